# Optimizing an MI355X kernel written in HIP

```python
import jax, jax.numpy as jnp
from jax import lax

D_MODEL = 2048
BATCH = 4
SEQ = 4096
DEPTH = 2

CHUNK = 64
Q_BLOCK = 128
ROPE_BASE = 10000.0
EPS = 1e-6
F32 = jnp.float32

MLA_HEADS = 8
MLA_Q_RANK = 512
MLA_KV_RANK = 256
MLA_NOPE = 128
MLA_ROPE = 64
MLA_V = 128
RET_HEADS = 8
RET_DK = 128
RET_DV = 128
MIX_WIDTH = MLA_HEADS * MLA_V + RET_HEADS * RET_DV

IN_SIZES = (MLA_Q_RANK, MLA_KV_RANK, MLA_ROPE,
            RET_HEADS * RET_DK, RET_HEADS * RET_DK, RET_HEADS * RET_DV, RET_HEADS * RET_DV)
IN_WIDTH = sum(IN_SIZES)
IN_OFFSETS = tuple(sum(IN_SIZES[:i + 1]) for i in range(len(IN_SIZES) - 1))

N_GROUPS = 4
EXPERTS_PER_GROUP = 8
N_EXPERTS = N_GROUPS * EXPERTS_PER_GROUP
TOP_K = 2
D_EXPERT = 512

kernel_name = 'hybrid_mla_retention_hmoe_block'


def rms_norm(x, g):
    xf = x.astype(F32)
    y = xf * lax.rsqrt(jnp.mean(xf * xf, axis=-1, keepdims=True) + EPS)
    return (y * g.astype(F32)).astype(x.dtype)


def rope(x, pos):
    half = x.shape[-1] // 2
    inv = ROPE_BASE ** (-jnp.arange(half, dtype=F32) / half)
    ang = pos.astype(F32)[:, None] * inv[None, :]
    cos = jnp.cos(ang)[None, :, None, :]
    sin = jnp.sin(ang)[None, :, None, :]
    xf = x.astype(F32)
    x1, x2 = xf[..., :half], xf[..., half:]
    return jnp.concatenate([x1 * cos - x2 * sin, x1 * sin + x2 * cos], axis=-1).astype(x.dtype)


def chunk_block_attention(q, k, v):
    S = q.shape[1]
    scale = q.shape[-1] ** -0.5
    outs = []
    for j in range(S // Q_BLOCK):
        q0, q1 = j * Q_BLOCK, (j + 1) * Q_BLOCK
        qb, kb, vb = q[:, q0:q1], k[:, :q1], v[:, :q1]
        s = jnp.einsum('bqhd,bkhd->bhqk', qb, kb, preferred_element_type=F32) * scale
        q_chunk = (q0 + jnp.arange(Q_BLOCK)) // CHUNK
        k_chunk = jnp.arange(q1) // CHUNK
        s = jnp.where(k_chunk[None, :] <= q_chunk[:, None], s, -jnp.inf)
        p = jax.nn.softmax(s, axis=-1).astype(vb.dtype)
        outs.append(jnp.einsum('bhqk,bkhd->bqhd', p, vb))
    return jnp.concatenate(outs, axis=1)


def chunkwise_retention(q, k, v):
    B, S, H, dk = q.shape
    dv = v.shape[-1]
    N = S // CHUNK
    log_g = jnp.log1p(-jnp.exp2(-5.0 - jnp.arange(H, dtype=F32)))
    q = q.astype(F32).reshape(B, N, CHUNK, H, dk)
    k = (k.astype(F32) * dk ** -0.5).reshape(B, N, CHUNK, H, dk)
    v = v.astype(F32).reshape(B, N, CHUNK, H, dv)
    idx = jnp.arange(CHUNK, dtype=F32)
    rel = idx[:, None] - idx[None, :]
    decay = jnp.where(rel[None] >= 0, jnp.exp(jnp.maximum(rel, 0.0)[None] * log_g[:, None, None]), 0.0)
    scores = jnp.einsum('bnqhd,bnkhd->bnhqk', q, k) * decay[None, None]
    y_intra = jnp.einsum('bnhqk,bnkhe->bnqhe', scores, v)
    k_dec = k * jnp.exp((CHUNK - 1.0 - idx)[:, None] * log_g[None, :])[None, None, :, :, None]
    U = jnp.einsum('bnkhd,bnkhe->nbhde', k_dec, v)
    chunk_decay = jnp.exp(CHUNK * log_g)[None, :, None, None]

    def step(state, u):
        return state * chunk_decay + u, state

    _, S_before = lax.scan(step, jnp.zeros((B, H, dk, dv), F32), U)
    q_dec = q * jnp.exp((idx + 1.0)[:, None] * log_g[None, :])[None, None, :, :, None]
    y_inter = jnp.einsum('bnqhd,nbhde->bnqhe', q_dec, S_before)
    return (y_intra + y_inter).reshape(B, S, H, dv)


def head_group_norm(y):
    mu = jnp.mean(y, axis=-1, keepdims=True)
    var = jnp.mean(jnp.square(y - mu), axis=-1, keepdims=True)
    return (y - mu) * lax.rsqrt(var + EPS)


def hybrid_mixer(h, w_in, q_norm_g, w_uq, kv_norm_g, w_ukv, w_o):
    B, S, _ = h.shape
    pos = jnp.arange(S, dtype=jnp.int32)
    proj = h @ w_in
    c_q, c_kv, k_pe, q_r, k_r, v_r, g_r = jnp.split(proj, list(IN_OFFSETS), axis=-1)

    q = (rms_norm(c_q, q_norm_g) @ w_uq).reshape(B, S, MLA_HEADS, MLA_NOPE + MLA_ROPE)
    q_nope, q_pe = q[..., :MLA_NOPE], rope(q[..., MLA_NOPE:], pos)
    kv = (rms_norm(c_kv, kv_norm_g) @ w_ukv).reshape(B, S, MLA_HEADS, MLA_NOPE + MLA_V)
    k_nope, v_mla = kv[..., :MLA_NOPE], kv[..., MLA_NOPE:]
    k_pe = rope(k_pe[:, :, None, :], pos)
    q_mla = jnp.concatenate([q_nope, q_pe], axis=-1)
    k_mla = jnp.concatenate([k_nope, jnp.broadcast_to(k_pe, (B, S, MLA_HEADS, MLA_ROPE))], axis=-1)
    y_mla = chunk_block_attention(q_mla, k_mla, v_mla).reshape(B, S, MLA_HEADS * MLA_V)

    q_r = rope(q_r.reshape(B, S, RET_HEADS, RET_DK), pos)
    k_r = rope(k_r.reshape(B, S, RET_HEADS, RET_DK), pos)
    v_r = v_r.reshape(B, S, RET_HEADS, RET_DV)
    y_ret = head_group_norm(chunkwise_retention(q_r, k_r, v_r)).reshape(B, S, RET_HEADS * RET_DV)
    y_ret = (jax.nn.silu(g_r.astype(F32)) * y_ret).astype(h.dtype)

    return jnp.concatenate([y_mla.astype(h.dtype), y_ret], axis=-1) @ w_o


def hier_moe(h, wg, bg, we, be, w_gate, w_up, w_down):
    B, S, D = h.shape
    T = B * S
    t = h.reshape(T, D)
    g_logits = (t @ wg + bg).astype(F32)
    g_prob = jax.nn.softmax(g_logits, axis=-1)
    _, g_sel = lax.top_k(g_logits, 1)
    g_sel = g_sel[:, 0]
    g_onehot = jax.nn.one_hot(g_sel, N_GROUPS, dtype=F32)
    p_group = jnp.sum(g_prob * g_onehot, axis=-1, keepdims=True)
    e_logits = (t @ we + be).astype(F32).reshape(T, N_GROUPS, EXPERTS_PER_GROUP)
    e_in_group = jnp.einsum('tg,tge->te', g_onehot, e_logits)
    top_logit, top_idx = lax.top_k(e_in_group, TOP_K)
    top_w = jax.nn.softmax(top_logit, axis=-1) * p_group
    expert_id = g_sel[:, None] * EXPERTS_PER_GROUP + top_idx
    gates = jnp.sum(jax.nn.one_hot(expert_id, N_EXPERTS, dtype=F32) * top_w[..., None], axis=1).astype(t.dtype)
    out = jnp.zeros((T, D), t.dtype)
    for gi in range(N_GROUPS):
        e0, e1 = gi * EXPERTS_PER_GROUP, (gi + 1) * EXPERTS_PER_GROUP
        a = jnp.einsum('td,edf->tef', t, w_gate[e0:e1])
        u = jnp.einsum('td,edf->tef', t, w_up[e0:e1])
        hid = jax.nn.silu(a) * u * gates[:, e0:e1, None]
        out = out + jnp.einsum('tef,efd->td', hid, w_down[e0:e1])
    return out.reshape(B, S, D)


def setup_inputs(seed: int = 0) -> dict:
    key = jax.random.key(seed)
    ks = jax.random.split(key, 24)
    L, D = DEPTH, D_MODEL

    def nrm(k, shape, s):
        return jax.random.normal(k, shape, F32) * s

    return {
        'x': nrm(ks[0], (BATCH, SEQ, D), 1.0),
        'c': nrm(ks[1], (BATCH, D), 1.0),
        'ada_w': nrm(ks[2], (L, D, 6 * D), 0.5 * D ** -0.5),
        'ada_b': nrm(ks[3], (L, 6 * D), 0.02),
        'norm1_g': 1.0 + nrm(ks[4], (L, D), 0.02),
        'w_in': nrm(ks[5], (L, D, IN_WIDTH), D ** -0.5),
        'q_norm_g': 1.0 + nrm(ks[6], (L, MLA_Q_RANK), 0.02),
        'w_uq': nrm(ks[7], (L, MLA_Q_RANK, MLA_HEADS * (MLA_NOPE + MLA_ROPE)), MLA_Q_RANK ** -0.5),
        'kv_norm_g': 1.0 + nrm(ks[8], (L, MLA_KV_RANK), 0.02),
        'w_ukv': nrm(ks[9], (L, MLA_KV_RANK, MLA_HEADS * (MLA_NOPE + MLA_V)), MLA_KV_RANK ** -0.5),
        'w_o': nrm(ks[10], (L, MIX_WIDTH, D), MIX_WIDTH ** -0.5),
        'norm2_g': 1.0 + nrm(ks[11], (L, D), 0.02),
        'router_group_w': nrm(ks[12], (L, D, N_GROUPS), D ** -0.5),
        'router_group_b': nrm(ks[13], (L, N_GROUPS), 0.01),
        'router_expert_w': nrm(ks[14], (L, D, N_EXPERTS), D ** -0.5),
        'router_expert_b': nrm(ks[15], (L, N_EXPERTS), 0.01),
        'w_gate': nrm(ks[16], (L, N_EXPERTS, D, D_EXPERT), D ** -0.5),
        'w_up': nrm(ks[17], (L, N_EXPERTS, D, D_EXPERT), D ** -0.5),
        'w_down': nrm(ks[18], (L, N_EXPERTS, D_EXPERT, D), D_EXPERT ** -0.5),
        'final_norm_g': 1.0 + nrm(ks[19], (D,), 0.02),
    }


def reference(x, c, ada_w, ada_b, norm1_g, w_in, q_norm_g, w_uq, kv_norm_g, w_ukv, w_o,
              norm2_g, router_group_w, router_group_b, router_expert_w, router_expert_b,
              w_gate, w_up, w_down, final_norm_g):
    for l in range(DEPTH):
        mod = jax.nn.silu(c) @ ada_w[l] + ada_b[l]
        sh1, sc1, g1, sh2, sc2, g2 = [m[:, None, :] for m in jnp.split(mod, 6, axis=-1)]
        h = rms_norm(x, norm1_g[l]) * (1.0 + sc1) + sh1
        x = x + g1 * hybrid_mixer(h, w_in[l], q_norm_g[l], w_uq[l], kv_norm_g[l], w_ukv[l], w_o[l])
        h = rms_norm(x, norm2_g[l]) * (1.0 + sc2) + sh2
        x = x + g2 * hier_moe(h, router_group_w[l], router_group_b[l], router_expert_w[l],
                              router_expert_b[l], w_gate[l], w_up[l], w_down[l])
    return rms_norm(x, final_norm_g)
```

```cpp
#include <hip/hip_runtime.h>
#include <cstdio>
#include <cstdint>

#define GAS __attribute__((address_space(1)))
#define LAS __attribute__((address_space(3)))
typedef unsigned short bf16;
typedef short bf16x8 __attribute__((ext_vector_type(8)));
typedef float f32x4 __attribute__((ext_vector_type(4)));
typedef float f32x16 __attribute__((ext_vector_type(16)));
typedef unsigned u32x4 __attribute__((ext_vector_type(4)));
typedef unsigned u32x2 __attribute__((ext_vector_type(2)));
typedef GAS unsigned gu32;

#define XB_TMO      128
#define XB_XCNT(j)  (256  + 64 * (j))
#define XB_XSUB(j)  (1280 + 64 * (j))
#define XB_XGEN(j)  (2304 + 64 * (j))
#define XB_TOP      3328
#define XB_TOPGEN   3392
#define XCD_BAR_WORDS 3456
#define XB_SPIN_CAP (1u << 22)

__device__ __forceinline__ unsigned xb_ld(unsigned* p)              { return __hip_atomic_load(p, __ATOMIC_RELAXED, __HIP_MEMORY_SCOPE_AGENT); }
__device__ __forceinline__ unsigned xb_add(unsigned* p, unsigned v) { return __hip_atomic_fetch_add(p, v, __ATOMIC_RELAXED, __HIP_MEMORY_SCOPE_AGENT); }
__device__ __forceinline__ unsigned xb_xcc_id() { return (unsigned)__builtin_amdgcn_s_getreg((3 << 11) | 20) & 0xFu; }
#define XB_SPIN(cond, bar) do { unsigned _sp = 0; while (cond) { __builtin_amdgcn_s_sleep(1); \
    if ((++_sp & 255u) == 0u) { if (xb_ld(&(bar)[XB_TMO])) break; if (_sp > XB_SPIN_CAP) { atomicAdd(&(bar)[XB_TMO], 1u); break; } } } } while (0)

struct XcdBarrier {
    unsigned* bar; unsigned x;
    volatile LAS unsigned* st;
};

__device__ __forceinline__ XcdBarrier xcd_barrier_post(unsigned* bar, volatile LAS unsigned* st) {
    XcdBarrier b; b.bar = bar; b.x = xb_xcc_id(); b.st = st;
    if (threadIdx.x == 0) (void)xb_add(&bar[XB_XCNT(b.x)], 1u);
    return b;
}
__device__ __forceinline__ void xcd_barrier_complete(unsigned* bar, unsigned x, unsigned& nloc, unsigned& nx) {
    const unsigned G = gridDim.x * gridDim.y * gridDim.z;
    unsigned sum, cnt, mine, sp = 0u;
    for (;;) {
        sum = 0u; cnt = 0u; mine = 0u;
#pragma unroll
        for (unsigned j = 0; j < 16; ++j) { const unsigned c = xb_ld(&bar[XB_XCNT(j)]); sum += c; cnt += (c > 0u) ? 1u : 0u; mine = (j == x) ? c : mine; }
        if (sum == G) break;
        __builtin_amdgcn_s_sleep(1);
        if ((++sp & 255u) == 0u) { if (xb_ld(&bar[XB_TMO])) break; if (sp > XB_SPIN_CAP) { atomicAdd(&bar[XB_TMO], 1u); break; } }
    }
    nloc = mine > 0u ? mine : 1u; nx = cnt > 0u ? cnt : 1u;
}

__device__ __forceinline__ void xcd_barrier(const XcdBarrier& b) {
    asm volatile("s_waitcnt vmcnt(0)" ::: "memory");
    __syncthreads();
    if (threadIdx.x == 0) {
        unsigned* bar = b.bar;
        __builtin_amdgcn_s_waitcnt(0);
        unsigned nloc = b.st[0], nx = b.st[1];
        if (nloc == 0u) { xcd_barrier_complete(bar, b.x, nloc, nx); b.st[0] = nloc; b.st[1] = nx; }
        const unsigned old = xb_add(&bar[XB_XSUB(b.x)], 1u);
        const unsigned gen = old / nloc;
        if (old + 1u == (gen + 1u) * nloc) {
            __builtin_amdgcn_fence(__ATOMIC_RELEASE, "agent");
            asm volatile("s_waitcnt vmcnt(0)" ::: "memory");
            const unsigned og = xb_add(&bar[XB_TOP], 1u);
            const unsigned tg = og / nx;
            if (og + 1u == (tg + 1u) * nx) xb_add(&bar[XB_TOPGEN], 1u);
            else XB_SPIN(xb_ld(&bar[XB_TOPGEN]) == tg, bar);
            __builtin_amdgcn_fence(__ATOMIC_ACQUIRE, "agent");
            xb_add(&bar[XB_XGEN(b.x)], 1u);
            asm volatile("s_waitcnt vmcnt(0)" ::: "memory");
        } else {
            XB_SPIN(xb_ld(&bar[XB_XGEN(b.x)]) == gen, bar);
            __builtin_amdgcn_fence(__ATOMIC_ACQUIRE, "agent");
            asm volatile("s_waitcnt vmcnt(0)" ::: "memory");
        }
    }
    __syncthreads();
}


constexpr int NB = 4, SEQ = 4096, T = NB * SEQ, D = 2048, NL = 2, NH = 8;
constexpr int INW = 4928, INP = 5120;
constexpr int NE = 32, DE = 512;
constexpr int MAXTILES = 160;
constexpr float EPS = 1e-6f;
constexpr int NWAVES = 8, NTHREADS = 512;
constexpr int PH_PER_LAYER = 13, PH_L0 = 2, PH_FINAL = PH_L0 + NL * PH_PER_LAYER, NPHASE = PH_FINAL + 1;
#ifndef MK_ONE_LAUNCH
#define MK_ONE_LAUNCH 1
#endif

constexpr size_t MiB = 1u << 20;
constexpr size_t WS_CTL = 0, CTL_ZERO_BYTES = 2 * MiB;
constexpr size_t WS_MOD = 2 * MiB, WS_C64 = 3 * MiB, WS_S64 = 4 * MiB, WS_C32 = 5 * MiB, WS_S32 = 5 * MiB + 512 * 1024, WS_MODP = 6 * MiB;
constexpr size_t WS_RQ = 18 * MiB, WS_RKV = WS_RQ + 65536, WS_LOGITS = 19 * MiB;
constexpr size_t WS_EID = 23 * MiB, WS_EW = WS_EID + 131072, WS_POS = WS_EW + 131072, WS_GW = WS_POS + 131072, WS_CNT = WS_GW + 163840, WS_TILE = WS_CNT + 32768;
constexpr size_t WS_WIN = 24 * MiB, WS_WUQ = 64 * MiB, WS_WUKV = 67 * MiB, WS_WO = 69 * MiB, WS_WR = 85 * MiB, WS_WGU = 88 * MiB, WS_WD = 344 * MiB;
constexpr size_t SZ_WIN = 20 * MiB, SZ_WUQ = 3 * MiB / 2, SZ_WUKV = 1 * MiB, SZ_WO = 8 * MiB, SZ_WR = 1 * MiB, SZ_WGU = 128 * MiB, SZ_WD = 64 * MiB;
constexpr size_t WS_H = 472 * MiB;
constexpr size_t WS_CQ = 536 * MiB, WS_CKV = 552 * MiB, WS_KPE = 560 * MiB, WS_QR = 562 * MiB, WS_KR = 594 * MiB, WS_VR = 626 * MiB, WS_GR = 658 * MiB;
constexpr size_t WS_QN = 690 * MiB, WS_QP = 722 * MiB, WS_KN = 738 * MiB, WS_V = 770 * MiB, WS_Y = 802 * MiB;
constexpr size_t WS_HS = 536 * MiB, WS_HID = 696 * MiB, WS_YM = 736 * MiB;
constexpr size_t WS_RETG = 896 * MiB, WS_END = 912 * MiB;
constexpr int CW_BAR = 4096;

constexpr int LDS_BYTES = 147456;
constexpr int LDS_MISC = 131072;
constexpr int LDS_BARW = 139264;

#define LDS_WAIT() asm volatile("s_waitcnt lgkmcnt(0)" ::: "memory")
__device__ __forceinline__ unsigned f2bf(float f) { unsigned u = __builtin_bit_cast(unsigned, f); return (u + 0x7fffu + ((u >> 16) & 1u)) >> 16; }
__device__ __forceinline__ unsigned pk2(float lo, float hi) { return f2bf(lo) | (f2bf(hi) << 16); }
__device__ __forceinline__ float bflo(unsigned w) { return __builtin_bit_cast(float, w << 16); }
__device__ __forceinline__ float bfhi(unsigned w) { return __builtin_bit_cast(float, w & 0xffff0000u); }
__device__ __forceinline__ void st4(bf16* p, f32x4 v) { u32x2 w; w.x = pk2(v.x, v.y); w.y = pk2(v.z, v.w); *(u32x2*)p = w; }
__device__ __forceinline__ float wave_sum(float v) {
#pragma unroll
    for (int o = 1; o < 64; o <<= 1) v += __shfl_xor(v, o);
    return v;
}
__device__ __forceinline__ float wave_max(float v) {
#pragma unroll
    for (int o = 1; o < 64; o <<= 1) v = fmaxf(v, __shfl_xor(v, o));
    return v;
}
__device__ __forceinline__ float silu_f(float v) { return v / (1.f + __expf(-v)); }

struct Args { const float* in[20]; float* out; unsigned char* ws; int ph_lo, ph_hi; };
enum { I_X = 0, I_C, I_ADAW, I_ADAB, I_N1G, I_WIN, I_QNG, I_WUQ, I_KVNG, I_WUKV, I_WO, I_N2G, I_RGW, I_RGB, I_REW, I_REB, I_WG, I_WU, I_WDN, I_FNG };

__device__ __forceinline__ void cvt_tile(const float* __restrict__ src, int ldsrc, int srccol0, const float* __restrict__ kgain, float scale,
                                         int K, bf16* __restrict__ dst, int dstrow0, int k0, LAS float* scr, int lane) {
    const int c = lane & 7;
    if (srccol0 < 0) {
#pragma unroll
        for (int j = 0; j < 4; ++j) { const int n = (lane >> 3) + 8 * j; *(u32x4*)(dst + (size_t)(dstrow0 + n) * K + k0 + 8 * c) = (u32x4){0u, 0u, 0u, 0u}; }
        return;
    }
#pragma unroll 8
    for (int i = 0; i < 32; ++i) { const int kk = 2 * i + (lane >> 5); const float g = kgain ? scale * kgain[k0 + kk] : scale;
        scr[kk * 33 + (lane & 31)] = g * src[(size_t)(k0 + kk) * ldsrc + srccol0 + (lane & 31)]; }
    LDS_WAIT(); asm volatile("" ::: "memory");
#pragma unroll
    for (int j = 0; j < 4; ++j) { const int n = (lane >> 3) + 8 * j; const LAS float* s = scr + (8 * c) * 33 + n;
        u32x4 o; o.x = pk2(s[0 * 33], s[1 * 33]); o.y = pk2(s[2 * 33], s[3 * 33]); o.z = pk2(s[4 * 33], s[5 * 33]); o.w = pk2(s[6 * 33], s[7 * 33]);
        *(u32x4*)(dst + (size_t)(dstrow0 + n) * K + k0 + 8 * c) = o; }
    LDS_WAIT(); asm volatile("" ::: "memory");
}
__device__ __forceinline__ int map_win(int n0, float& scale) {
    const int pn = n0 >> 8, c = n0 & 255; scale = 1.f;
    if (pn < 2) return n0;
    if (pn == 2) return 512 + c;
    if (pn < 11) { const int j = (pn < 7) ? pn - 3 : pn - 7, half = c >> 7, cc = c & 127, head = 2 * j + (cc >> 6), i = cc & 63;
        if (pn >= 7) scale = 0.08838834764831845f; return ((pn < 7) ? 832 : 1856) + head * 128 + half * 64 + i; }
    if (pn < 15) return 2880 + 256 * (pn - 11) + c;
    if (pn < 19) return 3904 + 256 * (pn - 15) + c;
    if (c < 32) return 768 + c;
    if (c >= 128 && c < 160) return 768 + 32 + (c - 128);
    return -1;
}
__device__ __forceinline__ int map_wuq(int n0) {
    if (n0 < 1024) return (n0 >> 7) * 192 + (n0 & 127);
    const int m = n0 - 1024, tile = m >> 8, c = m & 255, half = c >> 7, cc = c & 127, head = 4 * tile + (cc >> 5), i = cc & 31;
    return head * 192 + 128 + half * 32 + i;
}
__device__ __forceinline__ int map_wukv(int n0) {
    if (n0 < 1024) return (n0 >> 7) * 256 + (n0 & 127);
    const int m = n0 - 1024; return (m >> 7) * 256 + 128 + (m & 127);
}
constexpr int IT_WIN = 32 * 160, IT_WUQ = 8 * 48, IT_WUKV = 4 * 64, IT_WO = 32 * 64, IT_GU = 32 * 1024, IT_D = 32 * 512;
constexpr int IT_LAYER = IT_WIN + IT_WUQ + IT_WUKV + IT_WO + IT_GU + IT_D;
constexpr float QSCALE = 0.07216878364870322f * 1.4426950408889634f;

__device__ __forceinline__ void p0a(const Args& a, LAS unsigned char* lds) {
    const int tid = threadIdx.x, lane = tid & 63, wave = tid >> 6;
    unsigned char* ws = a.ws;
    {
        LAS float* sl = (LAS float*)(lds + LDS_MISC);
        float* modp = (float*)(ws + WS_MODP);
        for (int it = blockIdx.x; it < NL * 32 * 6; it += gridDim.x) {
            const int l = it / 192, r = it % 192, ks = r / 6, nb = r % 6, k0 = ks * 64;
            __syncthreads();
            if (tid < 256) { const int b = tid >> 6, k = tid & 63; sl[tid] = silu_f(a.in[I_C][b * D + k0 + k]); }
            __syncthreads();
            const float* w = a.in[I_ADAW] + (size_t)l * D * 6 * D + (size_t)k0 * 6 * D + nb * 2048 + tid * 4;
            f32x4 acc0 = {0.f, 0.f, 0.f, 0.f}, acc1 = acc0, acc2 = acc0, acc3 = acc0;
#pragma unroll 8
            for (int k = 0; k < 64; ++k) { const f32x4 wv = *(const f32x4*)(w + (size_t)k * 6 * D);
                acc0 += wv * sl[k]; acc1 += wv * sl[64 + k]; acc2 += wv * sl[128 + k]; acc3 += wv * sl[192 + k]; }
            float* o = modp + ((size_t)(l * 32 + ks) * 4) * 12288 + nb * 2048 + tid * 4;
            *(f32x4*)(o) = acc0; *(f32x4*)(o + 12288) = acc1; *(f32x4*)(o + 2 * 12288) = acc2; *(f32x4*)(o + 3 * 12288) = acc3;
        }
        __syncthreads();
    }
    {
        LAS float* scr = (LAS float*)(lds + wave * 16384);
        const int gw = blockIdx.x * NWAVES + wave, NGW = gridDim.x * NWAVES;
        for (int it = gw; it < NL * IT_LAYER; it += NGW) {
            const int l = it / IT_LAYER; int r = it % IT_LAYER;
            if (r < IT_WIN) { const int kb = r / 160, nb = r % 160; float sc; const int sc0 = map_win(nb * 32, sc);
                cvt_tile(a.in[I_WIN] + (size_t)l * D * INW, INW, sc0, nullptr, sc, D, (bf16*)(ws + WS_WIN + l * SZ_WIN), nb * 32, kb * 64, scr, lane); continue; }
            r -= IT_WIN;
            if (r < IT_WUQ) { const int kb = r / 48, nb = r % 48;
                cvt_tile(a.in[I_WUQ] + (size_t)l * 512 * 1536, 1536, map_wuq(nb * 32), a.in[I_QNG] + l * 512, QSCALE, 512, (bf16*)(ws + WS_WUQ + l * SZ_WUQ), nb * 32, kb * 64, scr, lane); continue; }
            r -= IT_WUQ;
            if (r < IT_WUKV) { const int kb = r / 64, nb = r % 64;
                cvt_tile(a.in[I_WUKV] + (size_t)l * 256 * 2048, 2048, map_wukv(nb * 32), a.in[I_KVNG] + l * 256, 1.f, 256, (bf16*)(ws + WS_WUKV + l * SZ_WUKV), nb * 32, kb * 64, scr, lane); continue; }
            r -= IT_WUKV;
            if (r < IT_WO) { const int kb = r / 64, nb = r % 64;
                cvt_tile(a.in[I_WO] + (size_t)l * D * D, D, nb * 32, nullptr, 1.f, D, (bf16*)(ws + WS_WO + l * SZ_WO), nb * 32, kb * 64, scr, lane); continue; }
            r -= IT_WO;
            if (r < IT_GU) { const int e = r / 1024, q = r % 1024, kb = q / 32, nb = q % 32, n0 = nb * 32, j = n0 >> 8, c = n0 & 255;
                const float* src = (c < 128 ? a.in[I_WG] : a.in[I_WU]) + ((size_t)(l * NE + e)) * D * DE;
                cvt_tile(src, DE, 128 * j + (c & 127), nullptr, 1.f, D, (bf16*)(ws + WS_WGU + l * SZ_WGU) + (size_t)e * 1024 * D, n0, kb * 64, scr, lane); continue; }
            r -= IT_GU;
            { const int e = r / 512, q = r % 512, kb = q / 64, nb = q % 64;
                cvt_tile(a.in[I_WDN] + ((size_t)(l * NE + e)) * DE * D, D, nb * 32, nullptr, 1.f, DE, (bf16*)(ws + WS_WD + l * SZ_WD) + (size_t)e * D * DE, nb * 32, kb * 64, scr, lane); }
        }
    }
    {
        const int gt = blockIdx.x * NTHREADS + tid, NGT = gridDim.x * NTHREADS;
        for (int i = gt; i < NL * 256 * D; i += NGT) { const int l = i / (256 * D), r = i % (256 * D), n = r / D, k = r % D; float v = 0.f;
            if (n < 4) v = a.in[I_RGW][(size_t)l * D * 4 + k * 4 + n]; else if (n < 36) v = a.in[I_REW][(size_t)l * D * 32 + k * 32 + (n - 4)];
            ((bf16*)(ws + WS_WR + l * SZ_WR))[(size_t)n * D + k] = (bf16)f2bf(v); }
        float* c64 = (float*)(ws + WS_C64); float* s64 = (float*)(ws + WS_S64); float* c32 = (float*)(ws + WS_C32); float* s32 = (float*)(ws + WS_S32);
        for (int i = gt; i < SEQ * 96; i += NGT) {
            const int pos = i / 96, q = i % 96, half = q < 64 ? 64 : 32, idx = q < 64 ? q : q - 64;
            const float inv = (float)exp2(-(double)idx / (double)half * 13.287712379549449);
            const float ang = (float)pos * inv;
            const double rev = (double)ang * 0.15915494309189535; const float fr = (float)(rev - floor(rev));
            const float sn = __builtin_amdgcn_sinf(fr), cs = __builtin_amdgcn_cosf(fr);
            if (q < 64) { c64[pos * 64 + idx] = cs; s64[pos * 64 + idx] = sn; } else { c32[pos * 32 + idx] = cs; s32[pos * 32 + idx] = sn; }
        }
    }
}
__device__ __forceinline__ void p0b(const Args& a) {
    const int gt = blockIdx.x * NTHREADS + threadIdx.x, NGT = gridDim.x * NTHREADS;
    const float* modp = (const float*)(a.ws + WS_MODP); float* mod = (float*)(a.ws + WS_MOD);
    for (int i = gt; i < NL * 4 * 12288; i += NGT) { const int l = i / (4 * 12288), r = i % (4 * 12288), b = r / 12288, n = r % 12288;
        float s = a.in[I_ADAB][l * 12288 + n];
        for (int ks = 0; ks < 32; ++ks) s += modp[((size_t)(l * 32 + ks) * 4 + b) * 12288 + n];
        mod[i] = s; }
}

__device__ __forceinline__ void adaln_rows(const float* __restrict__ x, const float* __restrict__ g, const float* __restrict__ modl  , int shoff, int scoff, bf16* __restrict__ out) {
    const int lane = threadIdx.x & 63, gw = blockIdx.x * NWAVES + (threadIdx.x >> 6), NGW = gridDim.x * NWAVES;
    for (int t = gw; t < T; t += NGW) {
        const f32x4* xr = (const f32x4*)(x + (size_t)t * D) + lane; const float* mb = modl + (t >> 12) * 12288;
        f32x4 v[8]; float ss = 0.f;
#pragma unroll
        for (int j = 0; j < 8; ++j) { v[j] = xr[64 * j]; ss += (v[j].x * v[j].x + v[j].y * v[j].y) + (v[j].z * v[j].z + v[j].w * v[j].w); }
        const float r = 1.f / sqrtf(wave_sum(ss) * (1.f / D) + EPS);
#pragma unroll
        for (int j = 0; j < 8; ++j) { const int c = 4 * lane + 256 * j;
            const f32x4 gv = *(const f32x4*)(g + c), sc = *(const f32x4*)(mb + scoff + c), sh = *(const f32x4*)(mb + shoff + c);
            const f32x4 y = v[j] * r * gv * (sc + 1.f) + sh; st4(out + (size_t)t * D + c, y); }
    }
}
__device__ __forceinline__ void final_rows(float* __restrict__ x, const float* __restrict__ g) {
    const int lane = threadIdx.x & 63, gw = blockIdx.x * NWAVES + (threadIdx.x >> 6), NGW = gridDim.x * NWAVES;
    for (int t = gw; t < T; t += NGW) {
        f32x4* xr = (f32x4*)(x + (size_t)t * D) + lane; f32x4 v[8]; float ss = 0.f;
#pragma unroll
        for (int j = 0; j < 8; ++j) { v[j] = xr[64 * j]; ss += (v[j].x * v[j].x + v[j].y * v[j].y) + (v[j].z * v[j].z + v[j].w * v[j].w); }
        const float r = 1.f / sqrtf(wave_sum(ss) * (1.f / D) + EPS);
#pragma unroll
        for (int j = 0; j < 8; ++j) { const f32x4 gv = *(const f32x4*)(g + 4 * lane + 256 * j); xr[64 * j] = v[j] * r * gv; }
    }
}
__device__ __forceinline__ void stats_rows(const bf16* __restrict__ cq, const bf16* __restrict__ ckv, float* __restrict__ rq, float* __restrict__ rkv) {
    const int lane = threadIdx.x & 63, gw = blockIdx.x * NWAVES + (threadIdx.x >> 6), NGW = gridDim.x * NWAVES;
    for (int t = gw; t < T; t += NGW) {
        const u32x4 w = *(const u32x4*)(cq + (size_t)t * 512 + lane * 8);
        float s = bflo(w.x) * bflo(w.x) + bfhi(w.x) * bfhi(w.x) + bflo(w.y) * bflo(w.y) + bfhi(w.y) * bfhi(w.y) + bflo(w.z) * bflo(w.z) + bfhi(w.z) * bfhi(w.z) + bflo(w.w) * bflo(w.w) + bfhi(w.w) * bfhi(w.w);
        s = wave_sum(s);
        float s2 = 0.f;
        if (lane < 32) { const u32x4 u = *(const u32x4*)(ckv + (size_t)t * 256 + lane * 8);
            s2 = bflo(u.x) * bflo(u.x) + bfhi(u.x) * bfhi(u.x) + bflo(u.y) * bflo(u.y) + bfhi(u.y) * bfhi(u.y) + bflo(u.z) * bflo(u.z) + bfhi(u.z) * bfhi(u.z) + bflo(u.w) * bflo(u.w) + bfhi(u.w) * bfhi(u.w); }
        s2 = wave_sum(s2);
        if (lane == 0) { rq[t] = 1.f / sqrtf(s * (1.f / 512.f) + EPS); rkv[t] = 1.f / sqrtf(s2 * (1.f / 256.f) + EPS); }
    }
}

struct BFixed { const bf16* p; __device__ __forceinline__ const bf16* operator()(int) const { return p; } };
struct BTile  { const bf16* p; size_t stride; const int* tile_e; __device__ __forceinline__ const bf16* operator()(int m0) const { return p + (size_t)tile_e[m0 >> 8] * stride; } };
template <class Epi, class BSel>
__device__ __forceinline__ void ngemm(const bf16* __restrict__ A, int lda, int mtiles64, int N, int K, const BSel& bsel, int ldb, const Epi& E) {
    const int tid = threadIdx.x, lane = tid & 63, wave = tid >> 6, rb = wave >> 2, cb = wave & 3, r = lane & 31, h = lane >> 5;
    const int nN = N >> 8, ntile = mtiles64 * nN;
    for (int tile = blockIdx.x; tile < ntile; tile += gridDim.x) {
        const int tm = tile / nN, tn = tile % nN, m0 = tm * 64, n0 = tn * 256;
        const bf16* Bt = bsel(m0);
        const bf16* ap = A + (size_t)(m0 + 32 * rb + r) * lda + 8 * h;
        const bf16* bp0 = Bt + (size_t)(n0 + 32 * cb + r) * ldb + 8 * h;
        const bf16* bp1 = bp0 + (size_t)128 * ldb;
        f32x16 acc0 = {}, acc1 = {};
#pragma unroll 4
        for (int k0 = 0; k0 < K; k0 += 16) {
            const bf16x8 av = *(const bf16x8*)(ap + k0), b0 = *(const bf16x8*)(bp0 + k0), b1 = *(const bf16x8*)(bp1 + k0);
            acc0 = __builtin_amdgcn_mfma_f32_32x32x16_bf16(b0, av, acc0, 0, 0, 0);
            acc1 = __builtin_amdgcn_mfma_f32_32x32x16_bf16(b1, av, acc1, 0, 0, 0);
        }
        const int row = m0 + 32 * rb + r;
#pragma unroll
        for (int g = 0; g < 4; ++g) { const int col = n0 + 32 * cb + 8 * g + 4 * h;
            E(row, col, (f32x4){acc0[4 * g], acc0[4 * g + 1], acc0[4 * g + 2], acc0[4 * g + 3]}, (f32x4){acc1[4 * g], acc1[4 * g + 1], acc1[4 * g + 2], acc1[4 * g + 3]}); }
    }
}

struct EpiInProj {
    bf16 *cq, *ckv, *kpe, *qr, *kr, *vr, *gr; const float *c64, *s64, *c32, *s32;
    __device__ __forceinline__ void operator()(int row, int col, f32x4 lo, f32x4 hi) const {
        const int pn = col >> 8, c = col & 255;
        if (pn < 2) { st4(cq + (size_t)row * 512 + col, lo); st4(cq + (size_t)row * 512 + col + 128, hi); }
        else if (pn == 2) { st4(ckv + (size_t)row * 256 + c, lo); st4(ckv + (size_t)row * 256 + c + 128, hi); }
        else if (pn < 11) { bf16* dst = pn < 7 ? qr : kr; const int j = pn < 7 ? pn - 3 : pn - 7, head = 2 * j + (c >> 6), i = c & 63, pos = row & (SEQ - 1);
            const f32x4 cs = *(const f32x4*)(c64 + pos * 64 + i), sn = *(const f32x4*)(s64 + pos * 64 + i);
            st4(dst + (size_t)row * 1024 + head * 128 + i, lo * cs - hi * sn); st4(dst + (size_t)row * 1024 + head * 128 + 64 + i, lo * sn + hi * cs); }
        else if (pn < 15) { bf16* p = vr + (size_t)row * 1024 + 256 * (pn - 11) + c; st4(p, lo); st4(p + 128, hi); }
        else if (pn < 19) { bf16* p = gr + (size_t)row * 1024 + 256 * (pn - 15) + c; st4(p, lo); st4(p + 128, hi); }
        else if (c < 32) { const int pos = row & (SEQ - 1);
            const f32x4 cs = *(const f32x4*)(c32 + pos * 32 + c), sn = *(const f32x4*)(s32 + pos * 32 + c);
            st4(kpe + (size_t)row * 64 + c, lo * cs - hi * sn); st4(kpe + (size_t)row * 64 + 32 + c, lo * sn + hi * cs); }
    }
};
struct EpiQ {
    bf16 *qn, *qp; const float *rq, *c32, *s32;
    __device__ __forceinline__ void operator()(int row, int col, f32x4 lo, f32x4 hi) const {
        const float r = rq[row]; lo = lo * r; hi = hi * r;
        if (col < 1024) { st4(qn + (size_t)row * 1024 + col, lo); st4(qn + (size_t)row * 1024 + col + 128, hi); }
        else { const int m = col - 1024, tile = m >> 8, c = m & 255, head = 4 * tile + (c >> 5), i = c & 31, pos = row & (SEQ - 1);
            const f32x4 cs = *(const f32x4*)(c32 + pos * 32 + i), sn = *(const f32x4*)(s32 + pos * 32 + i);
            st4(qp + (size_t)row * 512 + head * 64 + i, lo * cs - hi * sn); st4(qp + (size_t)row * 512 + head * 64 + 32 + i, lo * sn + hi * cs); }
    }
};
struct EpiKV {
    bf16 *kn, *v; const float* rkv;
    __device__ __forceinline__ void operator()(int row, int col, f32x4 lo, f32x4 hi) const {
        const float r = rkv[row]; lo = lo * r; hi = hi * r;
        bf16* p = (col < 1024 ? kn + (size_t)row * 1024 + col : v + (size_t)row * 1024 + (col - 1024)); st4(p, lo); st4(p + 128, hi);
    }
};
struct EpiWo {
    const float* xin; float* xout; const float* gate  ;
    __device__ __forceinline__ void operator()(int row, int col, f32x4 lo, f32x4 hi) const {
        const float* gb = gate + (row >> 12) * 12288 + col; const size_t o = (size_t)row * D + col;
        *(f32x4*)(xout + o) = *(const f32x4*)(xin + o) + *(const f32x4*)gb * lo;
        *(f32x4*)(xout + o + 128) = *(const f32x4*)(xin + o + 128) + *(const f32x4*)(gb + 128) * hi;
    }
};
struct EpiLogits { float* lg;
    __device__ __forceinline__ void operator()(int row, int col, f32x4 lo, f32x4) const { if (col < 64) *(f32x4*)(lg + (size_t)row * 64 + col) = lo; } };
struct EpiGateUp { bf16* hid; const float* gw;
    __device__ __forceinline__ void operator()(int row, int col, f32x4 lo, f32x4 hi) const {
        const int j = col >> 8, c = col & 255; const float w = gw[row];
        f32x4 o; o.x = silu_f(lo.x) * hi.x * w; o.y = silu_f(lo.y) * hi.y * w; o.z = silu_f(lo.z) * hi.z * w; o.w = silu_f(lo.w) * hi.w * w;
        st4(hid + (size_t)row * DE + 128 * j + c, o);
    }
};
struct EpiDown { bf16* ym;
    __device__ __forceinline__ void operator()(int row, int col, f32x4 lo, f32x4 hi) const { st4(ym + (size_t)row * D + col, lo); st4(ym + (size_t)row * D + col + 128, hi); } };

__device__ __forceinline__ void nmix_phase(const Args& a, LAS unsigned char* lds) {
    unsigned char* ws = a.ws;
    const int lane = threadIdx.x & 63, wave = threadIdx.x >> 6, gw = blockIdx.x * NWAVES + wave, NGW = gridDim.x * NWAVES;
    LAS float* qs = (LAS float*)(lds + wave * 1024);
    const bf16* QN = (const bf16*)(ws + WS_QN); const bf16* QP = (const bf16*)(ws + WS_QP); const bf16* KN = (const bf16*)(ws + WS_KN); const bf16* KPE = (const bf16*)(ws + WS_KPE);
    const bf16* VV = (const bf16*)(ws + WS_V); const bf16* QR = (const bf16*)(ws + WS_QR); const bf16* KR = (const bf16*)(ws + WS_KR); const bf16* VR = (const bf16*)(ws + WS_VR); const bf16* GR = (const bf16*)(ws + WS_GR);
    bf16* Y = (bf16*)(ws + WS_Y);
    for (int u = gw; u < 2 * T * NH; u += NGW) {
        const int hh = u & 7, t = (u >> 3) & (T - 1), mode = u >> 17, b = t >> 12, s = t & (SEQ - 1);
        LDS_WAIT();
        { const int idx = lane * 4; u32x2 w = {0u, 0u}; bool have = false;
          if (mode == 0) { if (idx < 128) { w = *(const u32x2*)(QN + (size_t)t * 1024 + hh * 128 + idx); have = true; } else if (idx < 192) { w = *(const u32x2*)(QP + (size_t)t * 512 + hh * 64 + idx - 128); have = true; } }
          else if (idx < 128) { w = *(const u32x2*)(QR + (size_t)t * 1024 + hh * 128 + idx); have = true; }
          if (have) { qs[idx] = bflo(w.x); qs[idx + 1] = bfhi(w.x); qs[idx + 2] = bflo(w.y); qs[idx + 3] = bfhi(w.y); } }
        LDS_WAIT(); asm volatile("" ::: "memory");
        const int ntile = (s >> 6) + 1;
        const float l2g = (float)log2(1.0 - exp2(-5.0 - (double)hh));
        float m = -1e30f, lsum = 0.f, o0 = 0.f, o1 = 0.f;
        for (int jt = 0; jt < ntile; ++jt) {
            const int sk = jt * 64 + lane; const size_t tk = (size_t)b * SEQ + sk;
            float dot = 0.f;
            if (mode == 0) {
#pragma unroll 4
                for (int d8 = 0; d8 < 24; ++d8) { const u32x4 kw = (d8 < 16) ? *(const u32x4*)(KN + tk * 1024 + hh * 128 + d8 * 8) : *(const u32x4*)(KPE + tk * 64 + (d8 - 16) * 8);
                    const LAS float* q = qs + d8 * 8;
                    dot += bflo(kw.x) * q[0] + bfhi(kw.x) * q[1] + bflo(kw.y) * q[2] + bfhi(kw.y) * q[3] + bflo(kw.z) * q[4] + bfhi(kw.z) * q[5] + bflo(kw.w) * q[6] + bfhi(kw.w) * q[7]; }
            } else {
#pragma unroll 4
                for (int d8 = 0; d8 < 16; ++d8) { const u32x4 kw = *(const u32x4*)(KR + tk * 1024 + hh * 128 + d8 * 8);
                    const LAS float* q = qs + d8 * 8;
                    dot += bflo(kw.x) * q[0] + bfhi(kw.x) * q[1] + bflo(kw.y) * q[2] + bfhi(kw.y) * q[3] + bflo(kw.z) * q[4] + bfhi(kw.z) * q[5] + bflo(kw.w) * q[6] + bfhi(kw.w) * q[7]; }
            }
            float p;
            if (mode == 0) { const float mn = fmaxf(m, wave_max(dot)); const float al = __builtin_amdgcn_exp2f(m - mn); p = __builtin_amdgcn_exp2f(dot - mn);
                lsum = lsum * al + wave_sum(p); o0 *= al; o1 *= al; m = mn; }
            else p = (sk <= s) ? dot * __builtin_amdgcn_exp2f((float)(s - sk) * l2g) : 0.f;
            const bf16* vb = (mode == 0 ? VV : VR) + ((size_t)b * SEQ + jt * 64) * 1024 + hh * 128 + 2 * lane;
#pragma unroll 8
            for (int j = 0; j < 64; ++j) { const float pj = __builtin_bit_cast(float, __builtin_amdgcn_readlane(__builtin_bit_cast(int, p), j));
                const unsigned vw = *(const unsigned*)(vb + (size_t)j * 1024); o0 += pj * bflo(vw); o1 += pj * bfhi(vw); }
        }
        if (mode == 0) { const float il = 1.f / lsum; *(unsigned*)(Y + (size_t)t * D + hh * 128 + 2 * lane) = pk2(o0 * il, o1 * il); }
        else { const float mu = wave_sum(o0 + o1) * (1.f / 128.f); const float d0 = o0 - mu, d1 = o1 - mu; const float var = wave_sum(d0 * d0 + d1 * d1) * (1.f / 128.f);
            const float rs = 1.f / sqrtf(var + EPS); const unsigned gwd = *(const unsigned*)(GR + (size_t)t * 1024 + hh * 128 + 2 * lane);
            *(unsigned*)(Y + (size_t)t * D + 1024 + hh * 128 + 2 * lane) = pk2(silu_f(bflo(gwd)) * d0 * rs, silu_f(bfhi(gwd)) * d1 * rs); }
    }
}

__device__ __forceinline__ void select_phase(const Args& a, int l) {
    unsigned char* ws = a.ws; const int lane = threadIdx.x & 63, wave = threadIdx.x >> 6;
    if (wave != 0) return;
    const float* lg = (const float*)(ws + WS_LOGITS); int* eid = (int*)(ws + WS_EID); float* ew = (float*)(ws + WS_EW); int* cnt = (int*)(ws + WS_CNT);
    const float* bg = a.in[I_RGB] + l * 4; const float* be = a.in[I_REB] + l * 32;
    for (int tb = blockIdx.x; tb < T / 64; tb += gridDim.x) {
        const int t = tb * 64 + lane; const float* r = lg + (size_t)t * 64;
        const f32x4 gl = *(const f32x4*)r; float g0 = gl.x + bg[0], g1 = gl.y + bg[1], g2 = gl.z + bg[2], g3 = gl.w + bg[3];
        int gs = 0; float gm = g0; if (g1 > gm) { gm = g1; gs = 1; } if (g2 > gm) { gm = g2; gs = 2; } if (g3 > gm) { gm = g3; gs = 3; }
        const float pg = 1.f / (__expf(g0 - gm) + __expf(g1 - gm) + __expf(g2 - gm) + __expf(g3 - gm));
        const f32x4 ea = *(const f32x4*)(r + 4 + gs * 8), eb = *(const f32x4*)(r + 8 + gs * 8); const float* bb = be + gs * 8;
        const float e0 = ea.x + bb[0], e1 = ea.y + bb[1], e2 = ea.z + bb[2], e3 = ea.w + bb[3], e4 = eb.x + bb[4], e5 = eb.y + bb[5], e6 = eb.z + bb[6], e7 = eb.w + bb[7];
        int i1 = 0; float m1 = e0;
        if (e1 > m1) { m1 = e1; i1 = 1; } if (e2 > m1) { m1 = e2; i1 = 2; } if (e3 > m1) { m1 = e3; i1 = 3; } if (e4 > m1) { m1 = e4; i1 = 4; } if (e5 > m1) { m1 = e5; i1 = 5; } if (e6 > m1) { m1 = e6; i1 = 6; } if (e7 > m1) { m1 = e7; i1 = 7; }
        int i2 = -1; float m2 = -3.0e38f;
        if (i1 != 0 && e0 > m2) { m2 = e0; i2 = 0; } if (i1 != 1 && e1 > m2) { m2 = e1; i2 = 1; } if (i1 != 2 && e2 > m2) { m2 = e2; i2 = 2; } if (i1 != 3 && e3 > m2) { m2 = e3; i2 = 3; }
        if (i1 != 4 && e4 > m2) { m2 = e4; i2 = 4; } if (i1 != 5 && e5 > m2) { m2 = e5; i2 = 5; } if (i1 != 6 && e6 > m2) { m2 = e6; i2 = 6; } if (i1 != 7 && e7 > m2) { m2 = e7; i2 = 7; }
        const float w1 = 1.f / (1.f + __expf(m2 - m1)), w2 = 1.f - w1;
        const int x1 = gs * 8 + i1, x2 = gs * 8 + i2;
        eid[2 * t] = x1; eid[2 * t + 1] = x2; ew[2 * t] = w1 * pg; ew[2 * t + 1] = w2 * pg;
        int my = 0;
        for (int e = 0; e < NE; ++e) { const int c = __popcll(__ballot(x1 == e)) + __popcll(__ballot(x2 == e)); if (lane == e) my = c; }
        if (lane < NE) cnt[tb * NE + lane] = my;
    }
}
__device__ __forceinline__ void dispatch_phase(const Args& a, LAS unsigned char* lds) {
    unsigned char* ws = a.ws; const int tid = threadIdx.x, lane = tid & 63, wave = tid >> 6;
    const int* eid = (const int*)(ws + WS_EID); const float* ew = (const float*)(ws + WS_EW); int* pos = (int*)(ws + WS_POS); float* gwt = (float*)(ws + WS_GW);
    const int* cnt = (const int*)(ws + WS_CNT); int* tile_e = (int*)(ws + WS_TILE);
    const bf16* h2 = (const bf16*)(ws + WS_H); bf16* hs = (bf16*)(ws + WS_HS);
    LAS int* posl = (LAS int*)(lds + LDS_MISC);
    for (int tb = blockIdx.x; tb < T / 64; tb += gridDim.x) {
        __syncthreads();
        if (wave == 0) {
            int total = 0, before = 0;
            if (lane < NE) for (int bb = 0; bb < T / 64; ++bb) { const int c = cnt[bb * NE + lane]; total += c; before += (bb < tb) ? c : 0; }
            const int padded = (total + 255) & ~255;
            int incl = padded;
#pragma unroll
            for (int o = 1; o < 32; o <<= 1) { const int v = __shfl_up(incl, o); if ((lane & 31) >= o) incl += v; }
            const int base = incl - padded;
            int start = base + before;
            if (tb == 0 && blockIdx.x == 0) {
                if (lane < NE) for (int i = 0; i < (padded >> 8); ++i) tile_e[(base >> 8) + i] = lane;
                if (lane == NE - 1) tile_e[MAXTILES] = (base + padded) >> 8;
            }
            const int t = tb * 64 + lane;
#pragma unroll
            for (int slot = 0; slot < 2; ++slot) {
                const int e_l = eid[2 * t + slot]; int p = 0;
                for (int e = 0; e < NE; ++e) { const unsigned long long mask = __ballot(e_l == e); const int st = __builtin_amdgcn_readlane(start, e);
                    if (e_l == e) p = st + __popcll(mask & ((1ull << lane) - 1ull)); if (lane == e) start += __popcll(mask); }
                pos[2 * t + slot] = p; gwt[p] = ew[2 * t + slot]; posl[slot * 64 + lane] = p;
            }
        }
        __syncthreads();
        for (int i = wave; i < 128; i += NWAVES) { const int t = tb * 64 + (i & 63), p = posl[i];
            const u32x4* src = (const u32x4*)(h2 + (size_t)t * D) + lane; u32x4* dst = (u32x4*)(hs + (size_t)p * D) + lane;
#pragma unroll
            for (int j = 0; j < 4; ++j) dst[64 * j] = src[64 * j]; }
    }
}
__device__ __forceinline__ void combine_rows(float* __restrict__ x, const bf16* __restrict__ ym, const int* __restrict__ pos, const float* __restrict__ gate  ) {
    const int lane = threadIdx.x & 63, gw = blockIdx.x * NWAVES + (threadIdx.x >> 6), NGW = gridDim.x * NWAVES;
    for (int t = gw; t < T; t += NGW) {
        const int p0 = pos[2 * t], p1 = pos[2 * t + 1]; const float* gb = gate + (t >> 12) * 12288;
#pragma unroll
        for (int j = 0; j < 8; ++j) { const int c = 4 * lane + 256 * j;
            const u32x2 y0 = *(const u32x2*)(ym + (size_t)p0 * D + c), y1 = *(const u32x2*)(ym + (size_t)p1 * D + c);
            const f32x4 s = {bflo(y0.x) + bflo(y1.x), bfhi(y0.x) + bfhi(y1.x), bflo(y0.y) + bflo(y1.y), bfhi(y0.y) + bfhi(y1.y)};
            f32x4* xp = (f32x4*)(x + (size_t)t * D + c); *xp = *xp + *(const f32x4*)(gb + c) * s; }
    }
}

__global__ void __launch_bounds__(NTHREADS, 2) fwd_kernel(Args a) {
    extern __shared__ __attribute__((aligned(16))) unsigned char lds_raw[];
    LAS unsigned char* lds = (LAS unsigned char*)lds_raw;
    unsigned char* ws = a.ws;
    const int lo = a.ph_lo, hi = a.ph_hi;
    if (threadIdx.x < 4) ((LAS unsigned*)(lds + LDS_BARW))[threadIdx.x] = 0u;
    __syncthreads();
    XcdBarrier bar; bar.bar = (unsigned*)(ws + WS_CTL) + CW_BAR; bar.x = 0; bar.st = nullptr;
    if (hi - lo > 1) bar = xcd_barrier_post((unsigned*)(ws + WS_CTL) + CW_BAR, (volatile LAS unsigned*)(lds + LDS_BARW));
#define IN(k) (lo <= (k) && (k) < hi)
#define SEAM(k) do { if (IN(k) && IN((k) + 1)) xcd_barrier(bar); } while (0)
    const float* mod = (const float*)(ws + WS_MOD);
    if (IN(0)) { p0a(a, lds); } SEAM(0);
    if (IN(1)) { p0b(a); } SEAM(1);
    for (int l = 0; l < NL; ++l) {
        const int pb = PH_L0 + l * PH_PER_LAYER; const float* modl = mod + l * 4 * 12288;
        const float* xin = (l == 0) ? a.in[I_X] : a.out;
        if (IN(pb + 0)) adaln_rows(xin, a.in[I_N1G] + l * D, modl, 0, 2048, (bf16*)(ws + WS_H)); SEAM(pb + 0);
        if (IN(pb + 1)) { EpiInProj E{(bf16*)(ws + WS_CQ), (bf16*)(ws + WS_CKV), (bf16*)(ws + WS_KPE), (bf16*)(ws + WS_QR), (bf16*)(ws + WS_KR), (bf16*)(ws + WS_VR), (bf16*)(ws + WS_GR),
                                      (const float*)(ws + WS_C64), (const float*)(ws + WS_S64), (const float*)(ws + WS_C32), (const float*)(ws + WS_S32)};
            ngemm(( const bf16*)(ws + WS_H), D, T / 64, INP, D, BFixed{(const bf16*)(ws + WS_WIN + l * SZ_WIN)}, D, E); } SEAM(pb + 1);
        if (IN(pb + 2)) stats_rows((const bf16*)(ws + WS_CQ), (const bf16*)(ws + WS_CKV), (float*)(ws + WS_RQ), (float*)(ws + WS_RKV)); SEAM(pb + 2);
        if (IN(pb + 3)) {
            { EpiQ E{(bf16*)(ws + WS_QN), (bf16*)(ws + WS_QP), (const float*)(ws + WS_RQ), (const float*)(ws + WS_C32), (const float*)(ws + WS_S32)};
              ngemm((const bf16*)(ws + WS_CQ), 512, T / 64, 1536, 512, BFixed{(const bf16*)(ws + WS_WUQ + l * SZ_WUQ)}, 512, E); }
            { EpiKV E{(bf16*)(ws + WS_KN), (bf16*)(ws + WS_V), (const float*)(ws + WS_RKV)};
              ngemm((const bf16*)(ws + WS_CKV), 256, T / 64, 2048, 256, BFixed{(const bf16*)(ws + WS_WUKV + l * SZ_WUKV)}, 256, E); }
        } SEAM(pb + 3);
        if (IN(pb + 4)) nmix_phase(a, lds); SEAM(pb + 4);
        if (IN(pb + 5)) { EpiWo E{xin, a.out, modl + 4096};
            ngemm((const bf16*)(ws + WS_Y), D, T / 64, D, D, BFixed{(const bf16*)(ws + WS_WO + l * SZ_WO)}, D, E); } SEAM(pb + 5);
        if (IN(pb + 6)) adaln_rows(a.out, a.in[I_N2G] + l * D, modl, 3 * 2048, 4 * 2048, (bf16*)(ws + WS_H)); SEAM(pb + 6);
        if (IN(pb + 7)) { EpiLogits E{(float*)(ws + WS_LOGITS)};
            ngemm((const bf16*)(ws + WS_H), D, T / 64, 256, D, BFixed{(const bf16*)(ws + WS_WR + l * SZ_WR)}, D, E); } SEAM(pb + 7);
        if (IN(pb + 8)) select_phase(a, l); SEAM(pb + 8);
        if (IN(pb + 9)) dispatch_phase(a, lds); SEAM(pb + 9);
        if (IN(pb + 10)) { const int* tile_e = (const int*)(ws + WS_TILE); const int nt = tile_e[MAXTILES];
            EpiGateUp E{(bf16*)(ws + WS_HID), (const float*)(ws + WS_GW)};
            ngemm((const bf16*)(ws + WS_HS), D, nt * 4, 1024, D, BTile{(const bf16*)(ws + WS_WGU + l * SZ_WGU), (size_t)1024 * D, tile_e}, D, E); } SEAM(pb + 10);
        if (IN(pb + 11)) { const int* tile_e = (const int*)(ws + WS_TILE); const int nt = tile_e[MAXTILES];
            EpiDown E{(bf16*)(ws + WS_YM)};
            ngemm((const bf16*)(ws + WS_HID), DE, nt * 4, D, DE, BTile{(const bf16*)(ws + WS_WD + l * SZ_WD), (size_t)D * DE, tile_e}, DE, E); } SEAM(pb + 11);
        if (IN(pb + 12)) combine_rows(a.out, (const bf16*)(ws + WS_YM), (const int*)(ws + WS_POS), modl + 5 * 2048); SEAM(pb + 12);
    }
    if (IN(PH_FINAL)) final_rows(a.out, a.in[I_FNG]);
#undef IN
#undef SEAM
}

extern "C" void kernel_launch(void* const* d_in, const int* in_sizes, int n_in, void* d_out, int out_size, void* d_ws, size_t ws_size, hipStream_t stream) {
    static int grid = 0;
    if (grid == 0) {
        if (n_in != 20 || out_size != T * D || ws_size < WS_END) { fprintf(stderr, "kernel_launch: unexpected shapes: n_in %d out %d ws %zu (need %zu)\n", n_in, out_size, ws_size, (size_t)WS_END); grid = -1; return; }
        int dev = 0, cus = 0, per_cu = 0;
        if (hipGetDevice(&dev) != hipSuccess || hipDeviceGetAttribute(&cus, hipDeviceAttributeMultiprocessorCount, dev) != hipSuccess) { grid = -1; return; }
        if (hipFuncSetAttribute((const void*)fwd_kernel, hipFuncAttributeMaxDynamicSharedMemorySize, LDS_BYTES) != hipSuccess) { fprintf(stderr, "kernel_launch: hipFuncSetAttribute failed\n"); grid = -1; return; }
        if (hipOccupancyMaxActiveBlocksPerMultiprocessor(&per_cu, (const void*)fwd_kernel, NTHREADS, LDS_BYTES) != hipSuccess || per_cu < 1) { fprintf(stderr, "kernel_launch: occupancy query says %d\n", per_cu); }
        (void)hipGetLastError();
        grid = cus;
    }
    if (grid < 0) return;
    if (hipMemsetAsync((char*)d_ws + WS_CTL, 0, CTL_ZERO_BYTES, stream) != hipSuccess) return;
    Args a{};
    for (int i = 0; i < 20; ++i) a.in[i] = (const float*)d_in[i];
    a.out = (float*)d_out; a.ws = (unsigned char*)d_ws;
#if MK_ONE_LAUNCH
    a.ph_lo = 0; a.ph_hi = NPHASE;
    hipLaunchKernelGGL(fwd_kernel, dim3(grid), dim3(NTHREADS), LDS_BYTES, stream, a);
#else
    for (int ph = 0; ph < NPHASE; ++ph) { a.ph_lo = ph; a.ph_hi = ph + 1;
        hipLaunchKernelGGL(fwd_kernel, dim3(grid), dim3(NTHREADS), LDS_BYTES, stream, a); }
#endif
    const hipError_t le = hipPeekAtLastError();
    if (le != hipSuccess) fprintf(stderr, "kernel_launch: launch failed: %s\n", hipGetErrorName(le));
}
```

```cpp
#include <hip/hip_runtime.h>
#include <cstdio>
#include <cstdint>

#define GAS __attribute__((address_space(1)))
#define LAS __attribute__((address_space(3)))
typedef unsigned short bf16;
typedef short bf16x8 __attribute__((ext_vector_type(8)));
typedef float f32x4 __attribute__((ext_vector_type(4)));
typedef float f32x16 __attribute__((ext_vector_type(16)));
typedef unsigned u32x4 __attribute__((ext_vector_type(4)));
typedef unsigned u32x2 __attribute__((ext_vector_type(2)));
typedef GAS unsigned gu32;

#define XB_TMO      128
#define XB_XCNT(j)  (256  + 64 * (j))
#define XB_XSUB(j)  (1280 + 64 * (j))
#define XB_XGEN(j)  (2304 + 64 * (j))
#define XB_TOP      3328
#define XB_TOPGEN   3392
#define XCD_BAR_WORDS 3456
#define XB_SPIN_CAP (1u << 22)

__device__ __forceinline__ unsigned xb_ld(unsigned* p)              { return __hip_atomic_load(p, __ATOMIC_RELAXED, __HIP_MEMORY_SCOPE_AGENT); }
__device__ __forceinline__ unsigned xb_add(unsigned* p, unsigned v) { return __hip_atomic_fetch_add(p, v, __ATOMIC_RELAXED, __HIP_MEMORY_SCOPE_AGENT); }
__device__ __forceinline__ unsigned xb_xcc_id() { return (unsigned)__builtin_amdgcn_s_getreg((3 << 11) | 20) & 0xFu; }
#define XB_SPIN(cond, bar) do { unsigned _sp = 0; while (cond) { __builtin_amdgcn_s_sleep(1); \
    if ((++_sp & 255u) == 0u) { if (xb_ld(&(bar)[XB_TMO])) break; if (_sp > XB_SPIN_CAP) { atomicAdd(&(bar)[XB_TMO], 1u); break; } } } } while (0)

__device__ __forceinline__ int olane() { int t; asm volatile("v_mbcnt_lo_u32_b32 %0, -1, 0\n\tv_mbcnt_hi_u32_b32 %0, -1, %0" : "=v"(t)); return t; }
struct XcdBarrier {
    unsigned* bar; unsigned x;
    volatile LAS unsigned* st;
};

__device__ __forceinline__ XcdBarrier xcd_barrier_post(unsigned* bar, volatile LAS unsigned* st) {
    XcdBarrier b; b.bar = bar; b.x = xb_xcc_id(); b.st = st;
    if (threadIdx.x == 0) (void)xb_add(&bar[XB_XCNT(b.x)], 1u);
    return b;
}
__device__ __forceinline__ void xcd_barrier_complete(unsigned* bar, unsigned x, unsigned& nloc, unsigned& nx) {
    const unsigned G = gridDim.x * gridDim.y * gridDim.z;
    unsigned sum, cnt, mine, sp = 0u;
    for (;;) {
        sum = 0u; cnt = 0u; mine = 0u;
#pragma unroll
        for (unsigned j = 0; j < 16; ++j) { const unsigned c = xb_ld(&bar[XB_XCNT(j)]); sum += c; cnt += (c > 0u) ? 1u : 0u; mine = (j == x) ? c : mine; }
        if (sum == G) break;
        __builtin_amdgcn_s_sleep(1);
        if ((++sp & 255u) == 0u) { if (xb_ld(&bar[XB_TMO])) break; if (sp > XB_SPIN_CAP) { atomicAdd(&bar[XB_TMO], 1u); break; } }
    }
    nloc = mine > 0u ? mine : 1u; nx = cnt > 0u ? cnt : 1u;
}

__device__ __forceinline__ void xcd_barrier(const XcdBarrier& b) {
    asm volatile("s_waitcnt vmcnt(0)" ::: "memory");
    __syncthreads();
    if (threadIdx.x == 0) {
        unsigned* bar = b.bar;
        __builtin_amdgcn_s_waitcnt(0);
        unsigned nloc = b.st[0], nx = b.st[1];
        if (nloc == 0u) { xcd_barrier_complete(bar, b.x, nloc, nx); b.st[0] = nloc; b.st[1] = nx; }
        const unsigned old = xb_add(&bar[XB_XSUB(b.x)], 1u);
        const unsigned gen = old / nloc;
        if (old + 1u == (gen + 1u) * nloc) {
            __builtin_amdgcn_fence(__ATOMIC_RELEASE, "agent");
            asm volatile("s_waitcnt vmcnt(0)" ::: "memory");
            const unsigned og = xb_add(&bar[XB_TOP], 1u);
            const unsigned tg = og / nx;
            if (og + 1u == (tg + 1u) * nx) xb_add(&bar[XB_TOPGEN], 1u);
            else XB_SPIN(xb_ld(&bar[XB_TOPGEN]) == tg, bar);
            __builtin_amdgcn_fence(__ATOMIC_ACQUIRE, "agent");
            xb_add(&bar[XB_XGEN(b.x)], 1u);
            asm volatile("s_waitcnt vmcnt(0)" ::: "memory");
        } else {
            XB_SPIN(xb_ld(&bar[XB_XGEN(b.x)]) == gen, bar);
            __builtin_amdgcn_fence(__ATOMIC_ACQUIRE, "agent");
            asm volatile("s_waitcnt vmcnt(0)" ::: "memory");
        }
    }
    __syncthreads();
}

namespace pg8 {
#define PG8_LAS __attribute__((address_space(3)))
typedef unsigned short bf16_t;
typedef short bf16x8 __attribute__((ext_vector_type(8)));
typedef float f32x4 __attribute__((ext_vector_type(4)));
typedef unsigned u32x4 __attribute__((ext_vector_type(4)));
constexpr int BM = 256, BK = 64, HALF = 128, HTB = HALF * BK * 2  , STAGE_BYTES = 8 * HTB, NXCD = 8, WGM = 8;

__host__ __device__ __forceinline__ int lds_byte(int r, int c) { const int st = (r >> 4) * 2 + (c >> 5), rr = r & 15, cc = c & 31, ob = rr * 64 + cc * 2; return st * 1024 + (ob ^ (((ob >> 9) & 1) << 5)); }
__host__ __device__ __forceinline__ void stage_rc(int b, int& R, int& C) { const int st = b / 1024, sb = b % 1024, swz = sb ^ (((sb >> 9) & 1) << 5); R = (st >> 1) * 16 + swz / 64; C = (st & 1) * 32 + (swz % 64) / 2; }
__host__ __device__ __forceinline__ int perm32(int rho) { const int n = rho >> 4, i = rho & 15; return 8 * (i >> 2) + 4 * n + (i & 3); }

struct Unit { int pm, pn; };
struct Gemm { const bf16_t* A; const bf16_t* Bt; int K, lda, ldb; };

struct StaticOrder {
    int nM, nN, nwg, G, c;
    __host__ __device__ void init(int M, int N, int G_, int c_) { nM = M / BM; nN = N / BM; nwg = nM * nN; G = G_; c = c_; }
    __host__ __device__ bool next(int i, Unit& u) const {
        const long L = (long)i * G + c; if (L >= nwg) return false;
        int wgid = (int)L; { const int q = nwg / NXCD, r = nwg % NXCD, xcd = wgid % NXCD, off = wgid / NXCD; wgid = (xcd < r ? xcd * (q + 1) : r * (q + 1) + (xcd - r) * q) + off; }
        const int nig = WGM * nN, gid = wgid / nig, fm = gid * WGM, gsz = (nM - fm) < WGM ? (nM - fm) : WGM;
        u.pm = fm + ((wgid % nig) % gsz); u.pn = (wgid % nig) / gsz; return true;
    }
    __device__ __forceinline__ void a_ready(const Unit&) const {}
    __device__ __forceinline__ void done(const Unit&) const {}
};

__device__ __forceinline__ unsigned cvt_pk_bf16(float lo, float hi) { unsigned r; asm volatile("v_cvt_pk_bf16_f32 %0, %1, %2" : "=v"(r) : "v"(lo), "v"(hi)); return r; }
template <class Epi, class Sched, bool ALIGN_EPI = false, bool SP2 = false>
__device__ __forceinline__ void gemm_phase(PG8_LAS unsigned char* lds, const Gemm g, const Sched& S, const Epi& E, int wv) {
    int tid_; asm volatile("v_mbcnt_lo_u32_b32 %0, -1, 0\n\tv_mbcnt_hi_u32_b32 %0, -1, %0" : "=v"(tid_)); tid_ |= wv << 6;
    const int tid = tid_, wid = __builtin_amdgcn_readfirstlane(tid >> 6), lane = tid & 63, wr = wid >> 2, wc = wid & 3, fr = lane & 15, fq = lane >> 4;
    const int K = g.K, nt = K / BK;
    unsigned voffA[2], voffB[2];
#pragma unroll
    for (int i = 0; i < 2; ++i) { int R, C; stage_rc(tid * 16 + i * 8192, R, C); const int Rb = Epi::PERM ? ((R & ~31) + perm32(R & 31)) : R;
        voffA[i] = (unsigned)(R * g.lda + C) * 2u; voffB[i] = (unsigned)(Rb * g.ldb + C) * 2u; }
    const size_t kstep = (size_t)(BK * 2);
    const size_t hstepA = (size_t)HALF * g.lda * 2, hstepB = (size_t)HALF * g.ldb * 2;
    const size_t tstepA = 2 * hstepA, tstepB = 2 * hstepB;
    const unsigned ldsw = (unsigned)wid * 1024u;
    const int aoff = lds_byte(wr * 64 + fr, fq * 8), boff = lds_byte(wc * 32 + fr, fq * 8);
#define PG8_SA(b, h) (((b) * 2 + (h)) * HTB)
#define PG8_SB(b, h) ((4 + (b) * 2 + (h)) * HTB)
#define PG8_STAGE(bufoff, gbase, voff) do { _Pragma("unroll") for (int _i = 0; _i < 2; ++_i) \
        __builtin_amdgcn_global_load_lds((const unsigned*)((const char*)(gbase) + (voff)[_i]), (PG8_LAS unsigned*)(lds + (bufoff) + ldsw + _i * 8192), 16, 0, 0); } while (0)
#define PG8_LDA(dst, b, h) do { _Pragma("unroll") for (int m = 0; m < 4; ++m) _Pragma("unroll") for (int k = 0; k < 2; ++k) dst[m][k] = *(const PG8_LAS bf16x8*)(lds + PG8_SA(b, h) + aoff + m * 2048 + k * 1024); } while (0)
#define PG8_LDB(dst, b, h) do { _Pragma("unroll") for (int n = 0; n < 2; ++n) _Pragma("unroll") for (int k = 0; k < 2; ++k) dst[n][k] = *(const PG8_LAS bf16x8*)(lds + PG8_SB(b, h) + boff + n * 2048 + k * 1024); } while (0)
#define PG8_MMA(ai, bj, At, Bt) do { __builtin_amdgcn_s_setprio(1); _Pragma("unroll") for (int m = 0; m < 4; ++m) _Pragma("unroll") for (int n = 0; n < 2; ++n) _Pragma("unroll") for (int k = 0; k < 2; ++k) \
        acc[ai][bj][m][n] = __builtin_amdgcn_mfma_f32_16x16x32_bf16(Bt[n][k], At[m][k], acc[ai][bj][m][n], 0, 0, 0); __builtin_amdgcn_s_setprio(0); } while (0)
#define PG8_WAIT_V(n) asm volatile("s_waitcnt vmcnt(" #n ")" ::: "memory")
#define PG8_WAIT_L(n) asm volatile("s_waitcnt lgkmcnt(" #n ")" ::: "memory")
#define PG8_BAR __builtin_amdgcn_s_barrier()
#define PG8_SCHED __builtin_amdgcn_sched_barrier(0)
    Unit cur, nxt; int ui = 0;
    if (!S.next(0, cur)) return;
    f32x4 acc[2][2][4][2];
#pragma unroll
    for (int a = 0; a < 2; ++a)
#pragma unroll
        for (int b = 0; b < 2; ++b)
#pragma unroll
            for (int m = 0; m < 4; ++m)
#pragma unroll
                for (int n = 0; n < 2; ++n) acc[a][b][m][n] = (f32x4){0.f, 0.f, 0.f, 0.f};
    bf16x8 At[4][2], B0[2][2], B1[2][2];
    const char* cA = (const char*)g.A + (size_t)cur.pm * tstepA; const char* cB = (const char*)g.Bt + (size_t)cur.pn * tstepB;
    S.a_ready(cur);
    if constexpr (SP2) {
        PG8_STAGE(PG8_SB(0, 0), cB, voffB); PG8_STAGE(PG8_SB(0, 1), cB + hstepB, voffB); PG8_STAGE(PG8_SA(0, 0), cA, voffA); PG8_STAGE(PG8_SA(0, 1), cA + hstepA, voffA);
        if (wr == 1) PG8_BAR;
        PG8_WAIT_V(2); PG8_BAR;
        PG8_STAGE(PG8_SB(1, 0), cB + kstep, voffB); PG8_STAGE(PG8_SA(1, 0), cA + kstep, voffA); PG8_STAGE(PG8_SB(1, 1), cB + hstepB + kstep, voffB);
        PG8_WAIT_V(6); PG8_BAR;
    } else {
        PG8_STAGE(PG8_SB(0, 0), cB, voffB); PG8_STAGE(PG8_SA(0, 0), cA, voffA); PG8_STAGE(PG8_SB(0, 1), cB + hstepB, voffB); PG8_STAGE(PG8_SA(0, 1), cA + hstepA, voffA);
        if (wr == 1) PG8_BAR;
        PG8_WAIT_V(4); PG8_BAR;
        PG8_STAGE(PG8_SB(1, 0), cB + kstep, voffB); PG8_STAGE(PG8_SA(1, 0), cA + kstep, voffA); PG8_STAGE(PG8_SB(1, 1), cB + hstepB + kstep, voffB);
        PG8_WAIT_V(6); PG8_BAR;
    }
    for (;;) {
        const bool has_next = S.next(ui + 1, nxt);
        const char* nA = has_next ? (const char*)g.A + (size_t)nxt.pm * tstepA : cA; const char* nB = has_next ? (const char*)g.Bt + (size_t)nxt.pn * tstepB : cB;
        for (int t = 0; t < nt; t += 2) {
            const bool last = (t == nt - 2);
            const char* a1 = cA + (size_t)(t + 1) * kstep;
            const char* a2 = last ? nA : cA + (size_t)(t + 2) * kstep; const char* b2 = last ? nB : cB + (size_t)(t + 2) * kstep;
            const char* a3 = a2 + kstep; const char* b3 = b2 + kstep;
            if (last && has_next) S.a_ready(nxt);
            if constexpr (SP2) {
            PG8_LDB(B0, 0, 0); PG8_LDB(B1, 0, 1); PG8_SCHED; PG8_LDA(At, 0, 0); PG8_STAGE(PG8_SA(1, 1), a1 + hstepA, voffA);
            PG8_WAIT_V(8); PG8_WAIT_L(0); PG8_BAR; PG8_MMA(0, 0, At, B0); PG8_MMA(0, 1, At, B1); PG8_BAR; PG8_SCHED;
            PG8_LDA(At, 0, 1); PG8_STAGE(PG8_SB(0, 0), b2, voffB); PG8_STAGE(PG8_SB(0, 1), b2 + hstepB, voffB); PG8_STAGE(PG8_SA(0, 0), a2, voffA);
            PG8_WAIT_V(8); PG8_WAIT_L(0); PG8_BAR; PG8_MMA(1, 0, At, B0); PG8_MMA(1, 1, At, B1); PG8_BAR; PG8_SCHED;
            PG8_LDB(B0, 1, 0); PG8_LDB(B1, 1, 1); PG8_SCHED; PG8_LDA(At, 1, 0); PG8_STAGE(PG8_SA(0, 1), a2 + hstepA, voffA);
            PG8_WAIT_V(8); PG8_WAIT_L(0); PG8_BAR; PG8_MMA(0, 0, At, B0); PG8_MMA(0, 1, At, B1); PG8_BAR; PG8_SCHED;
            PG8_LDA(At, 1, 1); PG8_STAGE(PG8_SB(1, 0), b3, voffB); PG8_STAGE(PG8_SB(1, 1), b3 + hstepB, voffB); PG8_STAGE(PG8_SA(1, 0), a3, voffA);
            PG8_WAIT_V(8); PG8_WAIT_L(0); PG8_BAR; PG8_MMA(1, 0, At, B0); PG8_MMA(1, 1, At, B1); PG8_BAR; PG8_SCHED;
            } else {
            PG8_LDB(B0, 0, 0); PG8_SCHED; PG8_LDA(At, 0, 0); PG8_STAGE(PG8_SA(1, 1), a1 + hstepA, voffA);
            PG8_WAIT_L(8); PG8_BAR; PG8_WAIT_L(0); PG8_MMA(0, 0, At, B0); PG8_BAR; PG8_SCHED;
            PG8_LDB(B1, 0, 1); PG8_STAGE(PG8_SB(0, 0), b2, voffB);
            PG8_BAR; PG8_WAIT_L(0); PG8_MMA(0, 1, At, B1); PG8_BAR;
            PG8_LDA(At, 0, 1); PG8_STAGE(PG8_SA(0, 0), a2, voffA);
            PG8_BAR; PG8_WAIT_L(0); PG8_MMA(1, 0, At, B0); PG8_BAR; PG8_SCHED;
            PG8_STAGE(PG8_SB(0, 1), b2 + hstepB, voffB);
            PG8_WAIT_V(6); PG8_BAR; PG8_MMA(1, 1, At, B1); PG8_BAR;
            PG8_LDB(B0, 1, 0); PG8_SCHED; PG8_LDA(At, 1, 0); PG8_STAGE(PG8_SA(0, 1), a2 + hstepA, voffA);
            PG8_WAIT_L(8); PG8_BAR; PG8_WAIT_L(0); PG8_MMA(0, 0, At, B0); PG8_BAR; PG8_SCHED;
            PG8_LDB(B1, 1, 1); PG8_STAGE(PG8_SB(1, 0), b3, voffB);
            PG8_BAR; PG8_WAIT_L(0); PG8_MMA(0, 1, At, B1); PG8_BAR;
            PG8_LDA(At, 1, 1); PG8_STAGE(PG8_SA(1, 0), a3, voffA);
            PG8_BAR; PG8_WAIT_L(0); PG8_MMA(1, 0, At, B0); PG8_BAR; PG8_SCHED;
            PG8_STAGE(PG8_SB(1, 1), b3 + hstepB, voffB);
            PG8_WAIT_V(6); PG8_BAR; PG8_MMA(1, 1, At, B1); PG8_BAR;
            }
        }
        if constexpr (ALIGN_EPI) { if (wr == 0) PG8_BAR; }
        if constexpr (!Epi::AFTER_DRAIN) { E(acc, cur, wr, wc, fr, fq); S.done(cur); }
        if (!has_next) break;
#pragma unroll
        for (int a = 0; a < 2; ++a)
#pragma unroll
            for (int b = 0; b < 2; ++b)
#pragma unroll
                for (int m = 0; m < 4; ++m)
#pragma unroll
                    for (int n = 0; n < 2; ++n) acc[a][b][m][n] = (f32x4){0.f, 0.f, 0.f, 0.f};
        cur = nxt; cA = nA; cB = nB; ++ui;
        if constexpr (ALIGN_EPI) { if (wr == 1) PG8_BAR; }
    }
    PG8_WAIT_V(0);
    if constexpr (!ALIGN_EPI) { if (wr == 0) PG8_BAR; }
    PG8_BAR;
    if constexpr (Epi::AFTER_DRAIN) { E.fused(acc, cur, wr, wc, fr, fq, lds, wid, lane); S.done(cur); }
#undef PG8_SA
#undef PG8_SB
#undef PG8_STAGE
#undef PG8_LDA
#undef PG8_LDB
#undef PG8_MMA
#undef PG8_WAIT_V
#undef PG8_WAIT_L
#undef PG8_BAR
#undef PG8_SCHED
}
}

constexpr int NB = 4, SEQ = 4096, T = NB * SEQ, D = 2048, NL = 2, NH = 8;
constexpr int INW = 4928, INP = 5120;
constexpr int NE = 32, DE = 512;
constexpr int MAXTILES = 160;
constexpr float EPS = 1e-6f;
constexpr int NWAVES = 8, NTHREADS = 512;
constexpr int PH_PER_LAYER = 13, PH_L0 = 2, PH_FINAL = PH_L0 + NL * PH_PER_LAYER, NPHASE = PH_FINAL + 1;
#ifndef MK_ONE_LAUNCH
#define MK_ONE_LAUNCH 1
#endif

constexpr size_t MiB = 1u << 20;
constexpr size_t WS_CTL = 0, CTL_ZERO_BYTES = 2 * MiB;
constexpr size_t WS_MOD = 2 * MiB, WS_C64 = 3 * MiB, WS_S64 = 4 * MiB, WS_C32 = 5 * MiB, WS_S32 = 5 * MiB + 512 * 1024, WS_MODP = 6 * MiB;
constexpr size_t WS_RQ = 18 * MiB, WS_RKV = WS_RQ + 65536, WS_LOGITS = 19 * MiB;
constexpr size_t WS_EID = 23 * MiB, WS_EW = WS_EID + 131072, WS_POS = WS_EW + 131072, WS_GW = WS_POS + 131072, WS_CNT = WS_GW + 163840, WS_TILE = WS_CNT + 32768;
constexpr size_t WS_WIN = 24 * MiB, WS_WUQ = 64 * MiB, WS_WUKV = 67 * MiB, WS_WO = 69 * MiB, WS_WR = 85 * MiB, WS_WGU = 88 * MiB, WS_WD = 344 * MiB;
constexpr size_t SZ_WIN = 20 * MiB, SZ_WUQ = 3 * MiB / 2, SZ_WUKV = 1 * MiB, SZ_WO = 8 * MiB, SZ_WR = 1 * MiB, SZ_WGU = 128 * MiB, SZ_WD = 64 * MiB;
constexpr size_t WS_H = 472 * MiB;
constexpr size_t WS_CQ = 536 * MiB, WS_CKV = 552 * MiB, WS_KPE = 560 * MiB, WS_QR = 562 * MiB, WS_KR = 594 * MiB, WS_VR = 626 * MiB, WS_GR = 658 * MiB;
constexpr size_t WS_QN = 690 * MiB, WS_QP = 722 * MiB, WS_KN = 738 * MiB, WS_V = 770 * MiB, WS_Y = 802 * MiB;
constexpr size_t WS_HS = 536 * MiB, WS_HID = 696 * MiB, WS_YM = 736 * MiB;
constexpr size_t WS_RETG = 896 * MiB, WS_END = 912 * MiB;
constexpr int CW_BAR = 4096;

constexpr int LDS_BYTES = 147456;
constexpr int LDS_MISC = 131072;
constexpr int LDS_BARW = 139264;

#define LDS_WAIT() asm volatile("s_waitcnt lgkmcnt(0)" ::: "memory")
__device__ __forceinline__ int otid(int wv) { return (wv << 6) | olane(); }
__device__ __forceinline__ unsigned f2bf(float f) { unsigned u = __builtin_bit_cast(unsigned, f); return (u + 0x7fffu + ((u >> 16) & 1u)) >> 16; }
__device__ __forceinline__ unsigned pk2(float lo, float hi) { return f2bf(lo) | (f2bf(hi) << 16); }
__device__ __forceinline__ float bflo(unsigned w) { return __builtin_bit_cast(float, w << 16); }
__device__ __forceinline__ float bfhi(unsigned w) { return __builtin_bit_cast(float, w & 0xffff0000u); }
__device__ __forceinline__ void st4(bf16* p, f32x4 v) { u32x2 w; w.x = pk2(v.x, v.y); w.y = pk2(v.z, v.w); *(u32x2*)p = w; }
__device__ __forceinline__ float lane_get(float v, int src) { return __builtin_bit_cast(float, __builtin_amdgcn_ds_bpermute(src << 2, __builtin_bit_cast(int, v))); }
__device__ __forceinline__ float wave_sum(float v) { const int ln = olane();
#pragma unroll
    for (int o = 1; o < 64; o <<= 1) v += lane_get(v, ln ^ o);
    return v;
}
__device__ __forceinline__ float wave_max(float v) { const int ln = olane();
#pragma unroll
    for (int o = 1; o < 64; o <<= 1) v = fmaxf(v, lane_get(v, ln ^ o));
    return v;
}
__device__ __forceinline__ float silu_f(float v) { return v / (1.f + __expf(-v)); }

struct Args { const float* in[20]; float* out; unsigned char* ws; int ph_lo, ph_hi; };
enum { I_X = 0, I_C, I_ADAW, I_ADAB, I_N1G, I_WIN, I_QNG, I_WUQ, I_KVNG, I_WUKV, I_WO, I_N2G, I_RGW, I_RGB, I_REW, I_REB, I_WG, I_WU, I_WDN, I_FNG };

__device__ __forceinline__ void cvt_tile(const float* __restrict__ src, int ldsrc, int srccol0, const float* __restrict__ kgain, float scale,
                                         int K, bf16* __restrict__ dst, int dstrow0, int k0, LAS float* scr, int lane) {
    const int c = lane & 7;
    if (srccol0 < 0) {
#pragma unroll
        for (int j = 0; j < 4; ++j) { const int n = (lane >> 3) + 8 * j; *(u32x4*)(dst + (size_t)(dstrow0 + n) * K + k0 + 8 * c) = (u32x4){0u, 0u, 0u, 0u}; }
        return;
    }
#pragma unroll 8
    for (int i = 0; i < 32; ++i) { const int kk = 2 * i + (lane >> 5); const float g = kgain ? scale * kgain[k0 + kk] : scale;
        scr[kk * 33 + (lane & 31)] = g * src[(size_t)(k0 + kk) * ldsrc + srccol0 + (lane & 31)]; }
    LDS_WAIT(); asm volatile("" ::: "memory");
#pragma unroll
    for (int j = 0; j < 4; ++j) { const int n = (lane >> 3) + 8 * j; const LAS float* s = scr + (8 * c) * 33 + n;
        u32x4 o; o.x = pk2(s[0 * 33], s[1 * 33]); o.y = pk2(s[2 * 33], s[3 * 33]); o.z = pk2(s[4 * 33], s[5 * 33]); o.w = pk2(s[6 * 33], s[7 * 33]);
        *(u32x4*)(dst + (size_t)(dstrow0 + n) * K + k0 + 8 * c) = o; }
    LDS_WAIT(); asm volatile("" ::: "memory");
}
__device__ __forceinline__ int map_win(int n0, float& scale) {
    const int pn = n0 >> 8, c = n0 & 255; scale = 1.f;
    if (pn < 2) return n0;
    if (pn == 2) return 512 + c;
    if (pn < 11) { const int j = (pn < 7) ? pn - 3 : pn - 7, half = c >> 7, cc = c & 127, head = 2 * j + (cc >> 6), i = cc & 63;
        if (pn >= 7) scale = 0.08838834764831845f; return ((pn < 7) ? 832 : 1856) + head * 128 + half * 64 + i; }
    if (pn < 15) return 2880 + 256 * (pn - 11) + c;
    if (pn < 19) return 3904 + 256 * (pn - 15) + c;
    if (c < 32) return 768 + c;
    if (c >= 128 && c < 160) return 768 + 32 + (c - 128);
    return -1;
}
__device__ __forceinline__ int map_wuq(int n0) {
    if (n0 < 1024) return (n0 >> 7) * 192 + (n0 & 127);
    const int m = n0 - 1024, tile = m >> 8, c = m & 255, half = c >> 7, cc = c & 127, head = 4 * tile + (cc >> 5), i = cc & 31;
    return head * 192 + 128 + half * 32 + i;
}
__device__ __forceinline__ int map_wukv(int n0) {
    if (n0 < 1024) return (n0 >> 7) * 256 + (n0 & 127);
    const int m = n0 - 1024; return (m >> 7) * 256 + 128 + (m & 127);
}
constexpr int IT_WIN = 32 * 160, IT_WUQ = 8 * 48, IT_WUKV = 4 * 64, IT_WO = 32 * 64, IT_GU = 32 * 1024, IT_D = 32 * 512;
constexpr int IT_LAYER = IT_WIN + IT_WUQ + IT_WUKV + IT_WO + IT_GU + IT_D;
constexpr float QSCALE = 0.07216878364870322f * 1.4426950408889634f;

__device__ __forceinline__ void p0a(const Args& a, LAS unsigned char* lds, int wv) {
    const int tid = otid(wv), lane = tid & 63, wave = tid >> 6;
    unsigned char* ws = a.ws;
    {
        LAS float* sl = (LAS float*)(lds + LDS_MISC);
        float* modp = (float*)(ws + WS_MODP);
        for (int it = blockIdx.x; it < NL * 32 * 6; it += gridDim.x) {
            const int l = it / 192, r = it % 192, ks = r / 6, nb = r % 6, k0 = ks * 64;
            __syncthreads();
            if (tid < 256) { const int b = tid >> 6, k = tid & 63; sl[tid] = silu_f(a.in[I_C][b * D + k0 + k]); }
            __syncthreads();
            const float* w = a.in[I_ADAW] + (size_t)l * D * 6 * D + (size_t)k0 * 6 * D + nb * 2048 + tid * 4;
            f32x4 acc0 = {0.f, 0.f, 0.f, 0.f}, acc1 = acc0, acc2 = acc0, acc3 = acc0;
#pragma unroll 8
            for (int k = 0; k < 64; ++k) { const f32x4 wv = *(const f32x4*)(w + (size_t)k * 6 * D);
                acc0 += wv * sl[k]; acc1 += wv * sl[64 + k]; acc2 += wv * sl[128 + k]; acc3 += wv * sl[192 + k]; }
            float* o = modp + ((size_t)(l * 32 + ks) * 4) * 12288 + nb * 2048 + tid * 4;
            *(f32x4*)(o) = acc0; *(f32x4*)(o + 12288) = acc1; *(f32x4*)(o + 2 * 12288) = acc2; *(f32x4*)(o + 3 * 12288) = acc3;
        }
        __syncthreads();
    }
    {
        LAS float* scr = (LAS float*)(lds + wave * 16384);
        const int gw = blockIdx.x * NWAVES + wave, NGW = gridDim.x * NWAVES;
        for (int it = gw; it < NL * IT_LAYER; it += NGW) {
            const int l = it / IT_LAYER; int r = it % IT_LAYER;
            if (r < IT_WIN) { const int kb = r / 160, nb = r % 160; float sc; const int sc0 = map_win(nb * 32, sc);
                cvt_tile(a.in[I_WIN] + (size_t)l * D * INW, INW, sc0, nullptr, sc, D, (bf16*)(ws + WS_WIN + l * SZ_WIN), nb * 32, kb * 64, scr, lane); continue; }
            r -= IT_WIN;
            if (r < IT_WUQ) { const int kb = r / 48, nb = r % 48;
                cvt_tile(a.in[I_WUQ] + (size_t)l * 512 * 1536, 1536, map_wuq(nb * 32), a.in[I_QNG] + l * 512, QSCALE, 512, (bf16*)(ws + WS_WUQ + l * SZ_WUQ), nb * 32, kb * 64, scr, lane); continue; }
            r -= IT_WUQ;
            if (r < IT_WUKV) { const int kb = r / 64, nb = r % 64;
                cvt_tile(a.in[I_WUKV] + (size_t)l * 256 * 2048, 2048, map_wukv(nb * 32), a.in[I_KVNG] + l * 256, 1.f, 256, (bf16*)(ws + WS_WUKV + l * SZ_WUKV), nb * 32, kb * 64, scr, lane); continue; }
            r -= IT_WUKV;
            if (r < IT_WO) { const int kb = r / 64, nb = r % 64;
                cvt_tile(a.in[I_WO] + (size_t)l * D * D, D, nb * 32, nullptr, 1.f, D, (bf16*)(ws + WS_WO + l * SZ_WO), nb * 32, kb * 64, scr, lane); continue; }
            r -= IT_WO;
            if (r < IT_GU) { const int e = r / 1024, q = r % 1024, kb = q / 32, nb = q % 32, n0 = nb * 32, j = n0 >> 8, c = n0 & 255;
                const float* src = (c < 128 ? a.in[I_WG] : a.in[I_WU]) + ((size_t)(l * NE + e)) * D * DE;
                cvt_tile(src, DE, 128 * j + (c & 127), nullptr, 1.f, D, (bf16*)(ws + WS_WGU + l * SZ_WGU) + (size_t)e * 1024 * D, n0, kb * 64, scr, lane); continue; }
            r -= IT_GU;
            { const int e = r / 512, q = r % 512, kb = q / 64, nb = q % 64;
                cvt_tile(a.in[I_WDN] + ((size_t)(l * NE + e)) * DE * D, D, nb * 32, nullptr, 1.f, DE, (bf16*)(ws + WS_WD + l * SZ_WD) + (size_t)e * D * DE, nb * 32, kb * 64, scr, lane); }
        }
    }
    {
        const int gt = blockIdx.x * NTHREADS + tid, NGT = gridDim.x * NTHREADS;
        for (int i = gt; i < NL * 256 * D; i += NGT) { const int l = i / (256 * D), r = i % (256 * D), n = r / D, k = r % D; float v = 0.f;
            if (n < 4) v = a.in[I_RGW][(size_t)l * D * 4 + k * 4 + n]; else if (n < 36) v = a.in[I_REW][(size_t)l * D * 32 + k * 32 + (n - 4)];
            ((bf16*)(ws + WS_WR + l * SZ_WR))[(size_t)n * D + k] = (bf16)f2bf(v); }
        float* c64 = (float*)(ws + WS_C64); float* s64 = (float*)(ws + WS_S64); float* c32 = (float*)(ws + WS_C32); float* s32 = (float*)(ws + WS_S32);
        for (int i = gt; i < SEQ * 96; i += NGT) {
            const int pos = i / 96, q = i % 96, half = q < 64 ? 64 : 32, idx = q < 64 ? q : q - 64;
            double invd = 1.0; { const double rr = half == 64 ? 0.8659643233600653 : 0.7498942093324559; for (int q2 = 0; q2 < idx; ++q2) invd *= rr; }
            const float inv = (float)invd;
            const float ang = (float)pos * inv;
            const double rev = (double)ang * 0.15915494309189535; const float fr = (float)(rev - floor(rev));
            const float sn = __builtin_amdgcn_sinf(fr), cs = __builtin_amdgcn_cosf(fr);
            if (q < 64) { c64[pos * 64 + idx] = cs; s64[pos * 64 + idx] = sn; } else { c32[pos * 32 + idx] = cs; s32[pos * 32 + idx] = sn; }
        }
    }
}
__device__ __forceinline__ void p0b(const Args& a, int wv) {
    const int gt = blockIdx.x * NTHREADS + otid(wv), NGT = gridDim.x * NTHREADS;
    const float* modp = (const float*)(a.ws + WS_MODP); float* mod = (float*)(a.ws + WS_MOD);
    for (int i = gt; i < NL * 4 * 12288; i += NGT) { const int l = i / (4 * 12288), r = i % (4 * 12288), b = r / 12288, n = r % 12288;
        float s = a.in[I_ADAB][l * 12288 + n];
        for (int ks = 0; ks < 32; ++ks) s += modp[((size_t)(l * 32 + ks) * 4 + b) * 12288 + n];
        mod[i] = s; }
}

__device__ __forceinline__ void adaln_rows(const float* __restrict__ x, const float* __restrict__ g, const float* __restrict__ modl  , int shoff, int scoff, bf16* __restrict__ out, int wv) {
    const int tid = otid(wv), lane = tid & 63, gw = blockIdx.x * NWAVES + (tid >> 6), NGW = gridDim.x * NWAVES;
    for (int t = gw; t < T; t += NGW) {
        const f32x4* xr = (const f32x4*)(x + (size_t)t * D) + lane; const float* mb = modl + (t >> 12) * 12288;
        f32x4 v[8]; float ss = 0.f;
#pragma unroll
        for (int j = 0; j < 8; ++j) { v[j] = xr[64 * j]; ss += (v[j].x * v[j].x + v[j].y * v[j].y) + (v[j].z * v[j].z + v[j].w * v[j].w); }
        const float r = 1.f / sqrtf(wave_sum(ss) * (1.f / D) + EPS);
#pragma unroll
        for (int j = 0; j < 8; ++j) { const int c = 4 * lane + 256 * j;
            const f32x4 gv = *(const f32x4*)(g + c), sc = *(const f32x4*)(mb + scoff + c), sh = *(const f32x4*)(mb + shoff + c);
            const f32x4 y = v[j] * r * gv * (sc + 1.f) + sh; st4(out + (size_t)t * D + c, y); }
    }
}
__device__ __forceinline__ void final_rows(float* __restrict__ x, const float* __restrict__ g, int wv) {
    const int tid = otid(wv), lane = tid & 63, gw = blockIdx.x * NWAVES + (tid >> 6), NGW = gridDim.x * NWAVES;
    for (int t = gw; t < T; t += NGW) {
        f32x4* xr = (f32x4*)(x + (size_t)t * D) + lane; f32x4 v[8]; float ss = 0.f;
#pragma unroll
        for (int j = 0; j < 8; ++j) { v[j] = xr[64 * j]; ss += (v[j].x * v[j].x + v[j].y * v[j].y) + (v[j].z * v[j].z + v[j].w * v[j].w); }
        const float r = 1.f / sqrtf(wave_sum(ss) * (1.f / D) + EPS);
#pragma unroll
        for (int j = 0; j < 8; ++j) { const f32x4 gv = *(const f32x4*)(g + 4 * lane + 256 * j); xr[64 * j] = v[j] * r * gv; }
    }
}
__device__ __forceinline__ void stats_rows(const bf16* __restrict__ cq, const bf16* __restrict__ ckv, float* __restrict__ rq, float* __restrict__ rkv, int wv) {
    const int tid = otid(wv), lane = tid & 63, gw = blockIdx.x * NWAVES + (tid >> 6), NGW = gridDim.x * NWAVES;
    for (int t = gw; t < T; t += NGW) {
        const u32x4 w = *(const u32x4*)(cq + (size_t)t * 512 + lane * 8);
        float s = bflo(w.x) * bflo(w.x) + bfhi(w.x) * bfhi(w.x) + bflo(w.y) * bflo(w.y) + bfhi(w.y) * bfhi(w.y) + bflo(w.z) * bflo(w.z) + bfhi(w.z) * bfhi(w.z) + bflo(w.w) * bflo(w.w) + bfhi(w.w) * bfhi(w.w);
        s = wave_sum(s);
        float s2 = 0.f;
        if (lane < 32) { const u32x4 u = *(const u32x4*)(ckv + (size_t)t * 256 + lane * 8);
            s2 = bflo(u.x) * bflo(u.x) + bfhi(u.x) * bfhi(u.x) + bflo(u.y) * bflo(u.y) + bfhi(u.y) * bfhi(u.y) + bflo(u.z) * bflo(u.z) + bfhi(u.z) * bfhi(u.z) + bflo(u.w) * bflo(u.w) + bfhi(u.w) * bfhi(u.w); }
        s2 = wave_sum(s2);
        if (lane == 0) { rq[t] = 1.f / sqrtf(s * (1.f / 512.f) + EPS); rkv[t] = 1.f / sqrtf(s2 * (1.f / 256.f) + EPS); }
    }
}

struct BFixed { const bf16* p; __device__ __forceinline__ const bf16* operator()(int) const { return p; } };
struct BTile  { const bf16* p; size_t stride; const int* tile_e; __device__ __forceinline__ const bf16* operator()(int m0) const { return p + (size_t)tile_e[m0 >> 8] * stride; } };
template <class Epi, class BSel>
__device__ __forceinline__ void ngemm(const bf16* __restrict__ A, int lda, int mtiles64, int N, int K, const BSel& bsel, int ldb, const Epi& E, int wv) {
    const int tid = otid(wv), lane = tid & 63, wave = tid >> 6, rb = wave >> 2, cb = wave & 3, r = lane & 31, h = lane >> 5;
    const int nN = N >> 8, ntile = mtiles64 * nN;
    for (int tile = blockIdx.x; tile < ntile; tile += gridDim.x) {
        const int tm = tile / nN, tn = tile % nN, m0 = tm * 64, n0 = tn * 256;
        const bf16* Bt = bsel(m0);
        const bf16* ap = A + (size_t)(m0 + 32 * rb + r) * lda + 8 * h;
        const bf16* bp0 = Bt + (size_t)(n0 + 32 * cb + r) * ldb + 8 * h;
        const bf16* bp1 = bp0 + (size_t)128 * ldb;
        f32x16 acc0 = {}, acc1 = {};
#pragma unroll 4
        for (int k0 = 0; k0 < K; k0 += 16) {
            const bf16x8 av = *(const bf16x8*)(ap + k0), b0 = *(const bf16x8*)(bp0 + k0), b1 = *(const bf16x8*)(bp1 + k0);
            acc0 = __builtin_amdgcn_mfma_f32_32x32x16_bf16(b0, av, acc0, 0, 0, 0);
            acc1 = __builtin_amdgcn_mfma_f32_32x32x16_bf16(b1, av, acc1, 0, 0, 0);
        }
        const int row = m0 + 32 * rb + r;
#pragma unroll
        for (int g = 0; g < 4; ++g) { const int col = n0 + 32 * cb + 8 * g + 4 * h;
            E(row, col, (f32x4){acc0[4 * g], acc0[4 * g + 1], acc0[4 * g + 2], acc0[4 * g + 3]}, (f32x4){acc1[4 * g], acc1[4 * g + 1], acc1[4 * g + 2], acc1[4 * g + 3]}); }
    }
}

struct EpiInProj {
    bf16 *cq, *ckv, *kpe, *qr, *kr, *vr, *gr; const float *c64, *s64, *c32, *s32;
    __device__ __forceinline__ void operator()(int row, int col, f32x4 lo, f32x4 hi) const {
        const int pn = col >> 8, c = col & 255;
        if (pn < 2) { st4(cq + (size_t)row * 512 + col, lo); st4(cq + (size_t)row * 512 + col + 128, hi); }
        else if (pn == 2) { st4(ckv + (size_t)row * 256 + c, lo); st4(ckv + (size_t)row * 256 + c + 128, hi); }
        else if (pn < 11) { bf16* dst = pn < 7 ? qr : kr; const int j = pn < 7 ? pn - 3 : pn - 7, head = 2 * j + (c >> 6), i = c & 63, pos = row & (SEQ - 1);
            const f32x4 cs = *(const f32x4*)(c64 + pos * 64 + i), sn = *(const f32x4*)(s64 + pos * 64 + i);
            st4(dst + (size_t)row * 1024 + head * 128 + i, lo * cs - hi * sn); st4(dst + (size_t)row * 1024 + head * 128 + 64 + i, lo * sn + hi * cs); }
        else if (pn < 15) { bf16* p = vr + (size_t)row * 1024 + 256 * (pn - 11) + c; st4(p, lo); st4(p + 128, hi); }
        else if (pn < 19) { bf16* p = gr + (size_t)row * 1024 + 256 * (pn - 15) + c; st4(p, lo); st4(p + 128, hi); }
        else if (c < 32) { const int pos = row & (SEQ - 1);
            const f32x4 cs = *(const f32x4*)(c32 + pos * 32 + c), sn = *(const f32x4*)(s32 + pos * 32 + c);
            st4(kpe + (size_t)row * 64 + c, lo * cs - hi * sn); st4(kpe + (size_t)row * 64 + 32 + c, lo * sn + hi * cs); }
    }
};
struct EpiQ {
    bf16 *qn, *qp; const float *rq, *c32, *s32;
    __device__ __forceinline__ void operator()(int row, int col, f32x4 lo, f32x4 hi) const {
        const float r = rq[row]; lo = lo * r; hi = hi * r;
        if (col < 1024) { st4(qn + (size_t)row * 1024 + col, lo); st4(qn + (size_t)row * 1024 + col + 128, hi); }
        else { const int m = col - 1024, tile = m >> 8, c = m & 255, head = 4 * tile + (c >> 5), i = c & 31, pos = row & (SEQ - 1);
            const f32x4 cs = *(const f32x4*)(c32 + pos * 32 + i), sn = *(const f32x4*)(s32 + pos * 32 + i);
            st4(qp + (size_t)row * 512 + head * 64 + i, lo * cs - hi * sn); st4(qp + (size_t)row * 512 + head * 64 + 32 + i, lo * sn + hi * cs); }
    }
};
struct EpiKV {
    bf16 *kn, *v; const float* rkv;
    __device__ __forceinline__ void operator()(int row, int col, f32x4 lo, f32x4 hi) const {
        const float r = rkv[row]; lo = lo * r; hi = hi * r;
        bf16* p = (col < 1024 ? kn + (size_t)row * 1024 + col : v + (size_t)row * 1024 + (col - 1024)); st4(p, lo); st4(p + 128, hi);
    }
};
struct EpiWo {
    const float* xin; float* xout; const float* gate  ;
    __device__ __forceinline__ void operator()(int row, int col, f32x4 lo, f32x4 hi) const {
        const float* gb = gate + (row >> 12) * 12288 + col; const size_t o = (size_t)row * D + col;
        *(f32x4*)(xout + o) = *(const f32x4*)(xin + o) + *(const f32x4*)gb * lo;
        *(f32x4*)(xout + o + 128) = *(const f32x4*)(xin + o + 128) + *(const f32x4*)(gb + 128) * hi;
    }
};
struct EpiLogits { float* lg;
    __device__ __forceinline__ void operator()(int row, int col, f32x4 lo, f32x4) const { if (col < 64) *(f32x4*)(lg + (size_t)row * 64 + col) = lo; } };
struct EpiGateUp { bf16* hid; const float* gw;
    __device__ __forceinline__ void operator()(int row, int col, f32x4 lo, f32x4 hi) const {
        const int j = col >> 8, c = col & 255; const float w = gw[row];
        f32x4 o; o.x = silu_f(lo.x) * hi.x * w; o.y = silu_f(lo.y) * hi.y * w; o.z = silu_f(lo.z) * hi.z * w; o.w = silu_f(lo.w) * hi.w * w;
        st4(hid + (size_t)row * DE + 128 * j + c, o);
    }
};
struct EpiDown { bf16* ym;
    __device__ __forceinline__ void operator()(int row, int col, f32x4 lo, f32x4 hi) const { st4(ym + (size_t)row * D + col, lo); st4(ym + (size_t)row * D + col + 128, hi); } };


template <class F> struct EpiPair {
    static constexpr bool PERM = false, AFTER_DRAIN = false;
    F f; int nn;
    __device__ __forceinline__ void operator()(const f32x4 (&acc)[2][2][4][2], const pg8::Unit& u, int wr, int wc, int fr, int fq) const {
        const int ln = olane();
        const int row0 = u.pm * 256 + wr * 64 + (ln & 15), col0 = (u.pn % nn) * 256 + wc * 32 + 4 * (ln >> 4); (void)fr; (void)fq;
#pragma unroll
        for (int ai = 0; ai < 2; ++ai)
#pragma unroll
            for (int m = 0; m < 4; ++m)
#pragma unroll
                for (int n = 0; n < 2; ++n) f(row0 + ai * 128 + m * 16, col0 + n * 16, acc[ai][0][m][n], acc[ai][1][m][n]);
    }
};
struct TileOrder {
    const int* tile_e; int ntiles, nn, G, c;
    __device__ __forceinline__ bool next(int i, pg8::Unit& u) const { const int L = i * G + c; if (L >= ntiles * nn) return false; const int pm = L / nn; u.pm = pm; u.pn = tile_e[pm] * nn + (L % nn); return true; }
    __device__ __forceinline__ void a_ready(const pg8::Unit&) const {}
    __device__ __forceinline__ void done(const pg8::Unit&) const {}
};
template <class F> __device__ __forceinline__ void fgemm(LAS unsigned char* lds, const bf16* A, int lda, const bf16* Bt, int ldb, int M, int N, int K, const F& f, int wv) {
    asm volatile("" : "+s"(A), "+s"(Bt));
    pg8::Gemm g{A, Bt, K, lda, ldb}; pg8::StaticOrder S; S.init(M, N, (int)gridDim.x, (int)blockIdx.x);
    EpiPair<F> E{f, 1 << 20};
    pg8::gemm_phase<EpiPair<F>, pg8::StaticOrder, true, true>(lds, g, S, E, wv);
}
template <class F> __device__ __forceinline__ void fgemm_moe(LAS unsigned char* lds, const bf16* A, int lda, const bf16* Bt, int ldb, const int* tile_e, int nn, int K, const F& f, int wv) {
    asm volatile("" : "+s"(A), "+s"(Bt), "+s"(tile_e));
    pg8::Gemm g{A, Bt, K, lda, ldb}; TileOrder S{tile_e, tile_e[MAXTILES], nn, (int)gridDim.x, (int)blockIdx.x};
    EpiPair<F> E{f, nn};
    pg8::gemm_phase<EpiPair<F>, TileOrder, true, true>(lds, g, S, E, wv);
}


namespace att {
using s16x4 = __attribute__((ext_vector_type(4))) short;
constexpr int SHM_V = 64 * 128 * 2, SHM_K = 64 * 192 * 2;
constexpr int OFF_V = 0, OFF_K = 3 * SHM_V, OFF_WS = 3 * SHM_V + 3 * SHM_K, LDS_BYTES_ATT = OFF_WS + 8 * 64 * 4;
constexpr float THR = 11.5f;
#define ATT_KSWZ(row, colB) ((row) * 384 + ((colB) ^ (((row) & 7) << 4)))
#define ATT_SBAR() __builtin_amdgcn_sched_barrier(0)
__device__ __forceinline__ int crow(int r, int hi) { return (r & 3) + 8 * (r >> 2) + 4 * hi; }
__device__ __forceinline__ unsigned cvtpk(float lo, float hi) { unsigned r; asm volatile("v_cvt_pk_bf16_f32 %0, %1, %2" : "=v"(r) : "v"(lo), "v"(hi)); return r; }

__device__ __forceinline__ void partialSM(f32x16& p0, f32x16& p1, float& m_reg, float& mn, float& alpha, bool masked) {
    float pmax = p0[0];
#pragma unroll
    for (int r = 1; r < 16; ++r) pmax = fmaxf(pmax, p0[r]);
#pragma unroll
    for (int r = 0; r < 16; ++r) pmax = fmaxf(pmax, p1[r]);
    { auto rr = __builtin_amdgcn_permlane32_swap(__float_as_uint(pmax), __float_as_uint(pmax), false, false);
      pmax = fmaxf(__uint_as_float(rr[0]), __uint_as_float(rr[1])); }
    pmax = masked ? -1e30f : pmax;
    if (__builtin_expect(__all(pmax - m_reg <= THR), 1)) { mn = m_reg; alpha = 1.f; }
    else { mn = fmaxf(m_reg, pmax); alpha = __builtin_amdgcn_exp2f(m_reg - mn); m_reg = mn; }
    const float sc = masked ? 0.f : 1.f, bias = masked ? -1e30f : -mn;
#pragma unroll
    for (int r = 0; r < 16; ++r) p0[r] = fmaf(p0[r], sc, bias);
#pragma unroll
    for (int r = 0; r < 16; ++r) p1[r] = fmaf(p1[r], sc, bias);
#pragma unroll
    for (int r = 0; r < 16; ++r) p0[r] = __builtin_amdgcn_exp2f(p0[r]);
}
__device__ __forceinline__ void finishSM(f32x16& p0, f32x16& p1, float alpha, float& l_reg, bf16x8& pa0, bf16x8& pa1, bf16x8& pa2, bf16x8& pa3) {
#pragma unroll
    for (int r = 0; r < 16; ++r) p1[r] = __builtin_amdgcn_exp2f(p1[r]);
    float ps = 0;
#pragma unroll
    for (int r = 0; r < 16; ++r) ps += p0[r];
#pragma unroll
    for (int r = 0; r < 16; ++r) ps += p1[r];
    { auto rr = __builtin_amdgcn_permlane32_swap(__float_as_uint(ps), __float_as_uint(ps), false, false);
      ps = __uint_as_float(rr[0]) + __uint_as_float(rr[1]); }
    l_reg = l_reg * alpha + ps;
#define ATT_PK4(P, BASE, OUT) do { unsigned a0 = cvtpk(P[BASE + 0], P[BASE + 1]), a1 = cvtpk(P[BASE + 2], P[BASE + 3]);   \
    unsigned b0 = cvtpk(P[BASE + 4], P[BASE + 5]), b1 = cvtpk(P[BASE + 6], P[BASE + 7]);                              \
    auto r0 = __builtin_amdgcn_permlane32_swap(a0, b0, false, false); auto r1 = __builtin_amdgcn_permlane32_swap(a1, b1, false, false); \
    u32x4 w = {r0[0], r1[0], r0[1], r1[1]}; OUT = __builtin_bit_cast(bf16x8, w); } while (0)
    ATT_PK4(p0, 0, pa0); ATT_PK4(p0, 8, pa1); ATT_PK4(p1, 0, pa2); ATT_PK4(p1, 8, pa3);
#undef ATT_PK4
}
__device__ __forceinline__ void qkt(f32x16& p0, f32x16& p1, const LAS unsigned char* Ks, const bf16x8 (&qr)[12], int r32, int hi) {
    p0 = f32x16{}; p1 = f32x16{};
#pragma unroll
    for (int d0 = 0; d0 < 12; ++d0) { const int cb = (d0 * 16 + hi * 8) * 2;
        const bf16x8 b0 = *(const LAS bf16x8*)(Ks + ATT_KSWZ(r32, cb));
        const bf16x8 b1 = *(const LAS bf16x8*)(Ks + ATT_KSWZ(32 + r32, cb));
        p0 = __builtin_amdgcn_mfma_f32_32x32x16_bf16(b0, qr[d0], p0, 0, 0, 0);
        p1 = __builtin_amdgcn_mfma_f32_32x32x16_bf16(b1, qr[d0], p1, 0, 0, 0); }
}
__device__ __forceinline__ int v_st(int k, int c) { const int kk = (k & ~0xC) | ((k & 4) << 1) | ((k & 8) >> 1); return ((kk >> 3) * 4 + (c >> 5)) * 512 + ((kk & 7) * 32 + (c & 31)) * 2; }
__device__ __forceinline__ int v_rd_base(int lane) { return ((lane & 3) << 3) | (((lane >> 2) & 3) << 6) | (((lane >> 4) & 1) << 5) | (((lane >> 5) & 1) << 8); }
constexpr int v_rd_off(int d0, int ks, int half) { return d0 * 512 + ks * 4096 + half * 2048; }
template <int OFF> __device__ __forceinline__ s16x4 tr_read(int vb) {
    s16x4 r; asm volatile("ds_read_b64_tr_b16 %0, %1 offset:%2" : "=&v"(r) : "v"(vb), "i"(OFF) : "memory"); return r;
}
template <int D0> __device__ __forceinline__ void pv_one(f32x16& od, int vb, bf16x8 pa0, bf16x8 pa1, bf16x8 pa2, bf16x8 pa3) {
    const s16x4 l0 = tr_read<v_rd_off(D0, 0, 0)>(vb), h0 = tr_read<v_rd_off(D0, 0, 1)>(vb), l1 = tr_read<v_rd_off(D0, 1, 0)>(vb), h1 = tr_read<v_rd_off(D0, 1, 1)>(vb);
    const s16x4 l2 = tr_read<v_rd_off(D0, 2, 0)>(vb), h2 = tr_read<v_rd_off(D0, 2, 1)>(vb), l3 = tr_read<v_rd_off(D0, 3, 0)>(vb), h3 = tr_read<v_rd_off(D0, 3, 1)>(vb);
    asm volatile("s_waitcnt lgkmcnt(0)" ::: "memory"); ATT_SBAR();
#define ATT_PK(L, H) (bf16x8){L[0], L[1], L[2], L[3], H[0], H[1], H[2], H[3]}
    od = __builtin_amdgcn_mfma_f32_32x32x16_bf16(pa0, ATT_PK(l0, h0), od, 0, 0, 0);
    od = __builtin_amdgcn_mfma_f32_32x32x16_bf16(pa1, ATT_PK(l1, h1), od, 0, 0, 0);
    od = __builtin_amdgcn_mfma_f32_32x32x16_bf16(pa2, ATT_PK(l2, h2), od, 0, 0, 0);
    od = __builtin_amdgcn_mfma_f32_32x32x16_bf16(pa3, ATT_PK(l3, h3), od, 0, 0, 0);
#undef ATT_PK
}
__device__ __forceinline__ void pv_d0(f32x16 (&o)[4], int vb, bf16x8 pa0, bf16x8 pa1, bf16x8 pa2, bf16x8 pa3) {
    pv_one<0>(o[0], vb, pa0, pa1, pa2, pa3); pv_one<1>(o[1], vb, pa0, pa1, pa2, pa3); pv_one<2>(o[2], vb, pa0, pa1, pa2, pa3); pv_one<3>(o[3], vb, pa0, pa1, pa2, pa3);
}
__device__ __forceinline__ void unit(const bf16* __restrict__ QN, const bf16* __restrict__ QP, const bf16* __restrict__ KN, const bf16* __restrict__ KPE, const bf16* __restrict__ Vg,
                                     bf16* __restrict__ Y, int b, int h, int qb, LAS unsigned char* lds, int wv) {
    int wid_ = wv; asm volatile("" : "+s"(wid_));
    const int lane = olane(), wid = wid_, tid = (wid << 6) | lane, r32 = lane & 31, hi = lane >> 5;
    LAS unsigned char* V_lds = lds + OFF_V; LAS unsigned char* K_lds = lds + OFF_K;
    LAS float* wsf = (LAS float*)(lds + OFF_WS) + wid * 64; LAS float* li_l = wsf; LAS float* al_l = wsf + 32;
    float m_reg = -1e30f, l_reg = 0; f32x16 o[4] = {}; bf16x8 qr[12];
    const size_t tb0 = (size_t)b * SEQ;
    const size_t tq = tb0 + qb * 256 + wid * 32 + r32;
    const int cw = 4 * qb + (wid >> 1);
#pragma unroll
    for (int d0 = 0; d0 < 8; ++d0) qr[d0] = *(const bf16x8*)(QN + tq * 1024 + h * 128 + d0 * 16 + hi * 8);
#pragma unroll
    for (int d0 = 0; d0 < 4; ++d0) qr[8 + d0] = *(const bf16x8*)(QP + tq * 512 + h * 64 + d0 * 16 + hi * 8);
    const char* ksrc[3]; unsigned kstp[3]; const char* vsrc[2];
#pragma unroll
    for (int i = 0; i < 3; ++i) { const int S = i * 512 + tid, row = S / 24, ps = S % 24, ls = (ps & ~7) | ((ps & 7) ^ (row & 7));
        if (ls < 16) { ksrc[i] = (const char*)(KN + (tb0 + row) * 1024 + h * 128 + ls * 8); kstp[i] = 64u * 1024u * 2u; }
        else         { ksrc[i] = (const char*)(KPE + (tb0 + row) * 64 + (ls - 16) * 8);      kstp[i] = 64u * 64u * 2u; } }
#pragma unroll
    for (int i = 0; i < 2; ++i) { const int S = i * 512 + tid, c = ((S >> 5) & 3) * 32 + (S & 3) * 8, kk = ((S >> 7) & 7) * 8 + ((S >> 2) & 7), k = (kk & ~0xC) | ((kk & 4) << 1) | ((kk & 8) >> 1);
        vsrc[i] = (const char*)(Vg + (tb0 + k) * 1024 + h * 128 + c); }
    const int vb0 = (int)(uintptr_t)V_lds + v_rd_base(lane);
    const unsigned ldsw = (unsigned)wid * 1024u;
#define ATT_ISSUE(j, slot) do { _Pragma("unroll") for (int _i = 0; _i < 3; ++_i) \
        __builtin_amdgcn_global_load_lds((const unsigned*)(ksrc[_i] + (size_t)(j) * kstp[_i]), (LAS unsigned*)(K_lds + (slot) * SHM_K + _i * 8192 + ldsw), 16, 0, 0); \
    _Pragma("unroll") for (int _i = 0; _i < 2; ++_i) \
        __builtin_amdgcn_global_load_lds((const unsigned*)(vsrc[_i] + (size_t)(j) * (64u * 1024u * 2u)), (LAS unsigned*)(V_lds + (slot) * SHM_V + _i * 8192 + ldsw), 16, 0, 0); } while (0)
#define ATT_LAND() do { asm volatile("s_waitcnt vmcnt(0)" ::: "memory"); __syncthreads(); } while (0)
#define ATT_RESC(a) do { if (__any((a) < 1.f)) { if (hi == 0) al_l[r32] = (a); asm volatile("s_waitcnt lgkmcnt(0)" ::: "memory"); \
    _Pragma("unroll") for (int d = 0; d < 4; ++d) _Pragma("unroll") for (int r = 0; r < 16; ++r) o[d][r] *= al_l[crow(r, hi)]; } } while (0)
    f32x16 pA0, pA1, pB0, pB1; float mnA, mnB, alA, alB; bf16x8 pa0, pa1, pa2, pa3; const int NT = 4 * (qb + 1);
    ATT_ISSUE(0, 0); ATT_LAND();
    ATT_ISSUE(1, 1);
    qkt(pA0, pA1, K_lds, qr, r32, hi); partialSM(pA0, pA1, m_reg, mnA, alA, false);
    int sc_ = 1, sp_ = 0;
#define ATT_STEP(j, PC0, PC1, mnC, alC, PP0, PP1, alP) do { \
        ATT_LAND(); \
        { const int sn_ = (sc_ == 2) ? 0 : sc_ + 1; if ((j) + 1 < NT) ATT_ISSUE((j) + 1, sn_); } \
        ATT_SBAR(); qkt(PC0, PC1, K_lds + sc_ * SHM_K, qr, r32, hi); \
        finishSM(PP0, PP1, alP, l_reg, pa0, pa1, pa2, pa3); ATT_SBAR(); \
        pv_d0(o, vb0 + sp_ * SHM_V, pa0, pa1, pa2, pa3); partialSM(PC0, PC1, m_reg, mnC, alC, (j) > cw); \
        ATT_RESC(alC); \
        sp_ = sc_; sc_ = (sc_ == 2) ? 0 : sc_ + 1; } while (0)
    for (int j = 1; j + 1 < NT; j += 2) {
        ATT_STEP(j, pB0, pB1, mnB, alB, pA0, pA1, alA);
        ATT_STEP(j + 1, pA0, pA1, mnA, alA, pB0, pB1, alB);
    }
    ATT_STEP(NT - 1, pB0, pB1, mnB, alB, pA0, pA1, alA);
    finishSM(pB0, pB1, alB, l_reg, pa0, pa1, pa2, pa3); ATT_SBAR();
    pv_d0(o, vb0 + sp_ * SHM_V, pa0, pa1, pa2, pa3);
    if (hi == 0) li_l[r32] = l_reg; asm volatile("s_waitcnt lgkmcnt(0)" ::: "memory");
    bf16* Ow = Y + (tb0 + qb * 256 + wid * 32) * (size_t)D + h * 128;
#pragma unroll
    for (int r = 0; r < 16; ++r) { const int orow = crow(r, hi); const float rl = __builtin_amdgcn_rcpf(li_l[orow]);
#pragma unroll
        for (int d0 = 0; d0 < 4; ++d0) Ow[(size_t)orow * D + d0 * 32 + r32] = (bf16)f2bf(o[d0][r] * rl); }
    __syncthreads();
#undef ATT_ISSUE
#undef ATT_LAND
#undef ATT_STEP
#undef ATT_RESC
}
}


namespace ret {
using att::s16x4;
constexpr int OFF_Q = 0, OFF_K = 16384, OFF_KD = 32768, OFF_V = 49152, OFF_ST = 65536, OFF_Y = 98304, YSTR = 132;
#define RET_SWZ(row, colB) ((row) * 256 + ((colB) ^ (((row) & 7) << 4)))
#define RET_PK(L, H) (bf16x8){L[0], L[1], L[2], L[3], H[0], H[1], H[2], H[3]}
__device__ __forceinline__ bf16x8 scale8(bf16x8 x, float f) {
    const u32x4 w = __builtin_bit_cast(u32x4, x); u32x4 o;
    o.x = att::cvtpk(bflo(w.x) * f, bfhi(w.x) * f); o.y = att::cvtpk(bflo(w.y) * f, bfhi(w.y) * f); o.z = att::cvtpk(bflo(w.z) * f, bfhi(w.z) * f); o.w = att::cvtpk(bflo(w.w) * f, bfhi(w.w) * f);
    return __builtin_bit_cast(bf16x8, o);
}
__device__ __forceinline__ void trfrags(int base, bf16x8& f0, bf16x8& f1, bf16x8& f2, bf16x8& f3) {
    const s16x4 l0 = att::tr_read<att::v_rd_off(0, 0, 0)>(base), h0 = att::tr_read<att::v_rd_off(0, 0, 1)>(base), l1 = att::tr_read<att::v_rd_off(0, 1, 0)>(base), h1 = att::tr_read<att::v_rd_off(0, 1, 1)>(base);
    const s16x4 l2 = att::tr_read<att::v_rd_off(0, 2, 0)>(base), h2 = att::tr_read<att::v_rd_off(0, 2, 1)>(base), l3 = att::tr_read<att::v_rd_off(0, 3, 0)>(base), h3 = att::tr_read<att::v_rd_off(0, 3, 1)>(base);
    asm volatile("s_waitcnt lgkmcnt(0)" ::: "memory"); __builtin_amdgcn_sched_barrier(0);
    f0 = RET_PK(l0, h0); f1 = RET_PK(l1, h1); f2 = RET_PK(l2, h2); f3 = RET_PK(l3, h3);
}
template <bool R1>
__device__ __forceinline__ void unit(const bf16* __restrict__ QR, const bf16* __restrict__ KR, const bf16* __restrict__ VR, const bf16* __restrict__ GR, bf16* __restrict__ Y, float* __restrict__ Gs,
                                     int b, int h, int g, LAS unsigned char* lds, int wv) {
    const int lane = olane(), tid = (wv << 6) | lane, r32 = lane & 31, hi = lane >> 5, nb = wv >> 2, eb = wv & 3;
    const float l2g = h == 0 ? -0.04580368961312479f : h == 1 ? -0.02272007650008353f : h == 2 ? -0.011315313227834146f : h == 3 ? -0.005646563141142063f : h == 4 ? -0.0028205190623786626f : h == 5 ? -0.0014095702546713536f : h == 6 ? -0.0007046129765893727f : -0.0003522634716290214f;
    const float g64 = __builtin_amdgcn_exp2f(64.f * l2g);
    const size_t t0 = (size_t)b * SEQ + g * 512;
    const int sr = tid >> 4, sc = (tid & 15) * 8;
    const float kf0 = __builtin_amdgcn_exp2f((float)(63 - sr) * l2g), kf1 = __builtin_amdgcn_exp2f((float)(31 - sr) * l2g);
    f32x16 S0 = {}, S1 = {};
    float* Gbh = Gs + (size_t)((b * NH + h) * 8) * 16384;
    if (!R1) {
        const float g512 = __builtin_amdgcn_exp2f(512.f * l2g);
        for (int gp = 0; gp < g; ++gp) { const float* gt = Gbh + (size_t)gp * 16384 + (32 * eb + r32);
#pragma unroll
            for (int r = 0; r < 16; ++r) { const int d = att::crow(r, hi);
                S0[r] = S0[r] * g512 + gt[(size_t)(64 * nb + d) * 128]; S1[r] = S1[r] * g512 + gt[(size_t)(64 * nb + 32 + d) * 128]; } }
    }
    bf16x8 q0, q1, k0, k1, v0, v1;
#define RET_LOAD(j) do { const size_t _o = (t0 + (j) * 64 + sr) * 1024 + h * 128 + sc; \
        if (!R1) { q0 = *(const bf16x8*)(QR + _o); q1 = *(const bf16x8*)(QR + _o + 32 * 1024); } \
        k0 = *(const bf16x8*)(KR + _o); k1 = *(const bf16x8*)(KR + _o + 32 * 1024); v0 = *(const bf16x8*)(VR + _o); v1 = *(const bf16x8*)(VR + _o + 32 * 1024); } while (0)
    RET_LOAD(0);
    const int vbV = (int)(uintptr_t)(lds + OFF_V) + att::v_rd_base(lane) + eb * 512;
    const int vbK = (int)(uintptr_t)(lds + OFF_KD) + att::v_rd_base(lane) + (2 * nb) * 512;
    for (int j = 0; j < 8; ++j) {
        asm volatile("s_waitcnt vmcnt(0)" ::: "memory");
        if (!R1) { *(LAS bf16x8*)(lds + OFF_Q + RET_SWZ(sr, sc * 2)) = q0; *(LAS bf16x8*)(lds + OFF_Q + RET_SWZ(32 + sr, sc * 2)) = q1;
                   *(LAS bf16x8*)(lds + OFF_K + RET_SWZ(sr, sc * 2)) = k0; *(LAS bf16x8*)(lds + OFF_K + RET_SWZ(32 + sr, sc * 2)) = k1; }
        *(LAS bf16x8*)(lds + OFF_KD + att::v_st(sr, sc)) = scale8(k0, kf0); *(LAS bf16x8*)(lds + OFF_KD + att::v_st(32 + sr, sc)) = scale8(k1, kf1);
        *(LAS bf16x8*)(lds + OFF_V + att::v_st(sr, sc)) = v0; *(LAS bf16x8*)(lds + OFF_V + att::v_st(32 + sr, sc)) = v1;
        if (!R1) {
#pragma unroll
            for (int gq = 0; gq < 4; ++gq) { const int e = 32 * eb + r32, dcol = 8 * gq + 4 * hi;
                u32x2 w0, w1; w0.x = att::cvtpk(S0[4 * gq], S0[4 * gq + 1]); w0.y = att::cvtpk(S0[4 * gq + 2], S0[4 * gq + 3]); w1.x = att::cvtpk(S1[4 * gq], S1[4 * gq + 1]); w1.y = att::cvtpk(S1[4 * gq + 2], S1[4 * gq + 3]);
                *(LAS u32x2*)(lds + OFF_ST + RET_SWZ(e, (64 * nb + dcol) * 2)) = w0; *(LAS u32x2*)(lds + OFF_ST + RET_SWZ(e, (64 * nb + 32 + dcol) * 2)) = w1; }
        }
        __syncthreads();
        if (j < 7) RET_LOAD(j + 1);
        f32x16 yacc = {};
        if (!R1) {
            f32x16 p0 = {}, p1 = {}; bf16x8 qf[8];
#pragma unroll
            for (int s = 0; s < 8; ++s) { const int cb = (s * 16 + hi * 8) * 2;
                const bf16x8 a0 = *(const LAS bf16x8*)(lds + OFF_K + RET_SWZ(r32, cb)), a1 = *(const LAS bf16x8*)(lds + OFF_K + RET_SWZ(32 + r32, cb));
                qf[s] = *(const LAS bf16x8*)(lds + OFF_Q + RET_SWZ(32 * nb + r32, cb));
                p0 = __builtin_amdgcn_mfma_f32_32x32x16_bf16(a0, qf[s], p0, 0, 0, 0); p1 = __builtin_amdgcn_mfma_f32_32x32x16_bf16(a1, qf[s], p1, 0, 0, 0); }
            const int n = 32 * nb + r32;
#pragma unroll
            for (int r = 0; r < 16; ++r) { const int d0 = n - att::crow(r, hi), d1 = d0 - 32;
                p0[r] = d0 >= 0 ? p0[r] * __builtin_amdgcn_exp2f((float)d0 * l2g) : 0.f; p1[r] = d1 >= 0 ? p1[r] * __builtin_amdgcn_exp2f((float)d1 * l2g) : 0.f; }
            bf16x8 pa0, pa1, pa2, pa3;
#define RET_PK4(P, BASE, OUT) do { unsigned a0_ = att::cvtpk(P[BASE + 0], P[BASE + 1]), a1_ = att::cvtpk(P[BASE + 2], P[BASE + 3]);   \
    unsigned b0_ = att::cvtpk(P[BASE + 4], P[BASE + 5]), b1_ = att::cvtpk(P[BASE + 6], P[BASE + 7]);                              \
    auto r0_ = __builtin_amdgcn_permlane32_swap(a0_, b0_, false, false); auto r1_ = __builtin_amdgcn_permlane32_swap(a1_, b1_, false, false); \
    u32x4 w_ = {r0_[0], r1_[0], r0_[1], r1_[1]}; OUT = __builtin_bit_cast(bf16x8, w_); } while (0)
            RET_PK4(p0, 0, pa0); RET_PK4(p0, 8, pa1); RET_PK4(p1, 0, pa2); RET_PK4(p1, 8, pa3);
#undef RET_PK4
            att::pv_one<0>(yacc, vbV, pa0, pa1, pa2, pa3);
            f32x16 yi = {};
#pragma unroll
            for (int s = 0; s < 8; ++s) { const int cb = (s * 16 + hi * 8) * 2;
                const bf16x8 bs = *(const LAS bf16x8*)(lds + OFF_ST + RET_SWZ(32 * eb + r32, cb));
                yi = __builtin_amdgcn_mfma_f32_32x32x16_bf16(qf[s], bs, yi, 0, 0, 0); }
#pragma unroll
            for (int r = 0; r < 16; ++r) yacc[r] += yi[r] * __builtin_amdgcn_exp2f((float)(32 * nb + att::crow(r, hi) + 1) * l2g);
        }
        {
            bf16x8 bv0, bv1, bv2, bv3, ak0, ak1, ak2, ak3;
            trfrags(vbV, bv0, bv1, bv2, bv3);
            trfrags(vbK, ak0, ak1, ak2, ak3);
#pragma unroll
            for (int r = 0; r < 16; ++r) { S0[r] *= g64; S1[r] *= g64; }
            S0 = __builtin_amdgcn_mfma_f32_32x32x16_bf16(ak0, bv0, S0, 0, 0, 0); S0 = __builtin_amdgcn_mfma_f32_32x32x16_bf16(ak1, bv1, S0, 0, 0, 0);
            S0 = __builtin_amdgcn_mfma_f32_32x32x16_bf16(ak2, bv2, S0, 0, 0, 0); S0 = __builtin_amdgcn_mfma_f32_32x32x16_bf16(ak3, bv3, S0, 0, 0, 0);
            trfrags(vbK + 512, ak0, ak1, ak2, ak3);
            S1 = __builtin_amdgcn_mfma_f32_32x32x16_bf16(ak0, bv0, S1, 0, 0, 0); S1 = __builtin_amdgcn_mfma_f32_32x32x16_bf16(ak1, bv1, S1, 0, 0, 0);
            S1 = __builtin_amdgcn_mfma_f32_32x32x16_bf16(ak2, bv2, S1, 0, 0, 0); S1 = __builtin_amdgcn_mfma_f32_32x32x16_bf16(ak3, bv3, S1, 0, 0, 0);
        }
        if (!R1) {
            LAS float* yb = (LAS float*)(lds + OFF_Y);
#pragma unroll
            for (int r = 0; r < 16; ++r) yb[(32 * nb + att::crow(r, hi)) * YSTR + 32 * eb + r32] = yacc[r];
        }
        __syncthreads();
        if (!R1) {
            const LAS float* yb = (const LAS float*)(lds + OFF_Y);
#pragma unroll
            for (int i = 0; i < 8; ++i) { const int n = 8 * wv + i; const size_t t = t0 + j * 64 + n;
                const float a0 = yb[n * YSTR + 2 * lane], a1 = yb[n * YSTR + 2 * lane + 1];
                const float mu = wave_sum(a0 + a1) * (1.f / 128.f), c0 = a0 - mu, c1 = a1 - mu;
                const float rs = 1.f / sqrtf(wave_sum(c0 * c0 + c1 * c1) * (1.f / 128.f) + EPS);
                const unsigned gw = *(const unsigned*)(GR + t * 1024 + h * 128 + 2 * lane);
                *(unsigned*)(Y + t * D + 1024 + h * 128 + 2 * lane) = pk2(silu_f(bflo(gw)) * c0 * rs, silu_f(bfhi(gw)) * c1 * rs); }
        }
    }
    if (R1) { float* gt = Gbh + (size_t)g * 16384 + (32 * eb + r32);
#pragma unroll
        for (int r = 0; r < 16; ++r) { const int d = att::crow(r, hi); gt[(size_t)(64 * nb + d) * 128] = S0[r]; gt[(size_t)(64 * nb + 32 + d) * 128] = S1[r]; } }
    __syncthreads();
#undef RET_LOAD
}
}

template <bool R1> __device__ __forceinline__ void ret_phase(unsigned char* ws, LAS unsigned char* lds, int wv) {
    for (int i = blockIdx.x; i < 256; i += gridDim.x) {
        const int bh = i >> 3, g = i & 7, b = bh >> 3, h = bh & 7;
        if (R1 && g == 7) continue;
        ret::unit<R1>((const bf16*)(ws + WS_QR), (const bf16*)(ws + WS_KR), (const bf16*)(ws + WS_VR), (const bf16*)(ws + WS_GR), (bf16*)(ws + WS_Y), (float*)(ws + WS_RETG), b, h, g, lds, wv);
    }
}
__device__ __forceinline__ void attn_phase(unsigned char* ws, LAS unsigned char* lds, int wv) {
    const int G = gridDim.x, bx = blockIdx.x;
    const int vcu = (G % 8 == 0) ? (bx % 8) * (G / 8) + bx / 8 : bx;
    for (int i = vcu; i < 256; i += G) {
        const int bh = i >> 3, p = i & 7, b = bh >> 3, h = bh & 7;
        for (int k = 0; k < 2; ++k)
            att::unit((const bf16*)(ws + WS_QN), (const bf16*)(ws + WS_QP), (const bf16*)(ws + WS_KN), (const bf16*)(ws + WS_KPE), (const bf16*)(ws + WS_V), (bf16*)(ws + WS_Y), b, h, k ? p : 15 - p, lds, wv);
    }
}
__device__ __forceinline__ void nmix_phase(const Args& a, LAS unsigned char* lds, int wv) {
    unsigned char* ws = a.ws;
    const int tid = otid(wv), lane = tid & 63, wave = tid >> 6, gw = blockIdx.x * NWAVES + wave, NGW = gridDim.x * NWAVES;
    LAS float* qs = (LAS float*)(lds + wave * 1024);
    const bf16* QN = (const bf16*)(ws + WS_QN); const bf16* QP = (const bf16*)(ws + WS_QP); const bf16* KN = (const bf16*)(ws + WS_KN); const bf16* KPE = (const bf16*)(ws + WS_KPE);
    const bf16* VV = (const bf16*)(ws + WS_V); const bf16* QR = (const bf16*)(ws + WS_QR); const bf16* KR = (const bf16*)(ws + WS_KR); const bf16* VR = (const bf16*)(ws + WS_VR); const bf16* GR = (const bf16*)(ws + WS_GR);
    bf16* Y = (bf16*)(ws + WS_Y);
    for (int u = T * NH + gw; u < 2 * T * NH; u += NGW) {
        const int hh = u & 7, t = (u >> 3) & (T - 1), mode = u >> 17, b = t >> 12, s = t & (SEQ - 1);
        LDS_WAIT();
        { const int idx = lane * 4; u32x2 w = {0u, 0u}; bool have = false;
          if (mode == 0) { if (idx < 128) { w = *(const u32x2*)(QN + (size_t)t * 1024 + hh * 128 + idx); have = true; } else if (idx < 192) { w = *(const u32x2*)(QP + (size_t)t * 512 + hh * 64 + idx - 128); have = true; } }
          else if (idx < 128) { w = *(const u32x2*)(QR + (size_t)t * 1024 + hh * 128 + idx); have = true; }
          if (have) { qs[idx] = bflo(w.x); qs[idx + 1] = bfhi(w.x); qs[idx + 2] = bflo(w.y); qs[idx + 3] = bfhi(w.y); } }
        LDS_WAIT(); asm volatile("" ::: "memory");
        const int ntile = (s >> 6) + 1;
        const float l2g = hh == 0 ? -0.04580368961312479f : hh == 1 ? -0.02272007650008353f : hh == 2 ? -0.011315313227834146f : hh == 3 ? -0.005646563141142063f : hh == 4 ? -0.0028205190623786626f : hh == 5 ? -0.0014095702546713536f : hh == 6 ? -0.0007046129765893727f : -0.0003522634716290214f;
        float m = -1e30f, lsum = 0.f, o0 = 0.f, o1 = 0.f;
        for (int jt = 0; jt < ntile; ++jt) {
            const int sk = jt * 64 + lane; const size_t tk = (size_t)b * SEQ + sk;
            float dot = 0.f;
            if (mode == 0) {
#pragma unroll 4
                for (int d8 = 0; d8 < 24; ++d8) { const u32x4 kw = (d8 < 16) ? *(const u32x4*)(KN + tk * 1024 + hh * 128 + d8 * 8) : *(const u32x4*)(KPE + tk * 64 + (d8 - 16) * 8);
                    const LAS float* q = qs + d8 * 8;
                    dot += bflo(kw.x) * q[0] + bfhi(kw.x) * q[1] + bflo(kw.y) * q[2] + bfhi(kw.y) * q[3] + bflo(kw.z) * q[4] + bfhi(kw.z) * q[5] + bflo(kw.w) * q[6] + bfhi(kw.w) * q[7]; }
            } else {
#pragma unroll 4
                for (int d8 = 0; d8 < 16; ++d8) { const u32x4 kw = *(const u32x4*)(KR + tk * 1024 + hh * 128 + d8 * 8);
                    const LAS float* q = qs + d8 * 8;
                    dot += bflo(kw.x) * q[0] + bfhi(kw.x) * q[1] + bflo(kw.y) * q[2] + bfhi(kw.y) * q[3] + bflo(kw.z) * q[4] + bfhi(kw.z) * q[5] + bflo(kw.w) * q[6] + bfhi(kw.w) * q[7]; }
            }
            float p;
            if (mode == 0) { const float mn = fmaxf(m, wave_max(dot)); const float al = __builtin_amdgcn_exp2f(m - mn); p = __builtin_amdgcn_exp2f(dot - mn);
                lsum = lsum * al + wave_sum(p); o0 *= al; o1 *= al; m = mn; }
            else p = (sk <= s) ? dot * __builtin_amdgcn_exp2f((float)(s - sk) * l2g) : 0.f;
            const bf16* vb = (mode == 0 ? VV : VR) + ((size_t)b * SEQ + jt * 64) * 1024 + hh * 128 + 2 * lane;
#pragma unroll 8
            for (int j = 0; j < 64; ++j) { const float pj = __builtin_bit_cast(float, __builtin_amdgcn_readlane(__builtin_bit_cast(int, p), j));
                const unsigned vw = *(const unsigned*)(vb + (size_t)j * 1024); o0 += pj * bflo(vw); o1 += pj * bfhi(vw); }
        }
        if (mode == 0) { const float il = 1.f / lsum; *(unsigned*)(Y + (size_t)t * D + hh * 128 + 2 * lane) = pk2(o0 * il, o1 * il); }
        else { const float mu = wave_sum(o0 + o1) * (1.f / 128.f); const float d0 = o0 - mu, d1 = o1 - mu; const float var = wave_sum(d0 * d0 + d1 * d1) * (1.f / 128.f);
            const float rs = 1.f / sqrtf(var + EPS); const unsigned gwd = *(const unsigned*)(GR + (size_t)t * 1024 + hh * 128 + 2 * lane);
            *(unsigned*)(Y + (size_t)t * D + 1024 + hh * 128 + 2 * lane) = pk2(silu_f(bflo(gwd)) * d0 * rs, silu_f(bfhi(gwd)) * d1 * rs); }
    }
}

__device__ __forceinline__ void select_phase(const Args& a, int l, int wv) {
    unsigned char* ws = a.ws; const int tid = otid(wv), lane = tid & 63, wave = tid >> 6;
    if (wave != 0) return;
    const float* lg = (const float*)(ws + WS_LOGITS); int* eid = (int*)(ws + WS_EID); float* ew = (float*)(ws + WS_EW); int* cnt = (int*)(ws + WS_CNT);
    const float* bg = a.in[I_RGB] + l * 4; const float* be = a.in[I_REB] + l * 32;
    for (int tb = blockIdx.x; tb < T / 64; tb += gridDim.x) {
        const int t = tb * 64 + lane; const float* r = lg + (size_t)t * 64;
        const f32x4 gl = *(const f32x4*)r; float g0 = gl.x + bg[0], g1 = gl.y + bg[1], g2 = gl.z + bg[2], g3 = gl.w + bg[3];
        int gs = 0; float gm = g0; if (g1 > gm) { gm = g1; gs = 1; } if (g2 > gm) { gm = g2; gs = 2; } if (g3 > gm) { gm = g3; gs = 3; }
        const float pg = 1.f / (__expf(g0 - gm) + __expf(g1 - gm) + __expf(g2 - gm) + __expf(g3 - gm));
        const f32x4 ea = *(const f32x4*)(r + 4 + gs * 8), eb = *(const f32x4*)(r + 8 + gs * 8); const float* bb = be + gs * 8;
        const float e0 = ea.x + bb[0], e1 = ea.y + bb[1], e2 = ea.z + bb[2], e3 = ea.w + bb[3], e4 = eb.x + bb[4], e5 = eb.y + bb[5], e6 = eb.z + bb[6], e7 = eb.w + bb[7];
        int i1 = 0; float m1 = e0;
        if (e1 > m1) { m1 = e1; i1 = 1; } if (e2 > m1) { m1 = e2; i1 = 2; } if (e3 > m1) { m1 = e3; i1 = 3; } if (e4 > m1) { m1 = e4; i1 = 4; } if (e5 > m1) { m1 = e5; i1 = 5; } if (e6 > m1) { m1 = e6; i1 = 6; } if (e7 > m1) { m1 = e7; i1 = 7; }
        int i2 = -1; float m2 = -3.0e38f;
        if (i1 != 0 && e0 > m2) { m2 = e0; i2 = 0; } if (i1 != 1 && e1 > m2) { m2 = e1; i2 = 1; } if (i1 != 2 && e2 > m2) { m2 = e2; i2 = 2; } if (i1 != 3 && e3 > m2) { m2 = e3; i2 = 3; }
        if (i1 != 4 && e4 > m2) { m2 = e4; i2 = 4; } if (i1 != 5 && e5 > m2) { m2 = e5; i2 = 5; } if (i1 != 6 && e6 > m2) { m2 = e6; i2 = 6; } if (i1 != 7 && e7 > m2) { m2 = e7; i2 = 7; }
        const float w1 = 1.f / (1.f + __expf(m2 - m1)), w2 = 1.f - w1;
        const int x1 = gs * 8 + i1, x2 = gs * 8 + i2;
        eid[2 * t] = x1; eid[2 * t + 1] = x2; ew[2 * t] = w1 * pg; ew[2 * t + 1] = w2 * pg;
        int my = 0;
        for (int e = 0; e < NE; ++e) { const int c = __popcll(__ballot(x1 == e)) + __popcll(__ballot(x2 == e)); if (lane == e) my = c; }
        if (lane < NE) cnt[tb * NE + lane] = my;
    }
}
__device__ __forceinline__ void dispatch_phase(const Args& a, LAS unsigned char* lds, int wv) {
    unsigned char* ws = a.ws; const int tid = otid(wv), lane = tid & 63, wave = tid >> 6;
    const int* eid = (const int*)(ws + WS_EID); const float* ew = (const float*)(ws + WS_EW); int* pos = (int*)(ws + WS_POS); float* gwt = (float*)(ws + WS_GW);
    const int* cnt = (const int*)(ws + WS_CNT); int* tile_e = (int*)(ws + WS_TILE);
    const bf16* h2 = (const bf16*)(ws + WS_H); bf16* hs = (bf16*)(ws + WS_HS);
    LAS int* posl = (LAS int*)(lds + LDS_MISC);
    for (int tb = blockIdx.x; tb < T / 64; tb += gridDim.x) {
        __syncthreads();
        if (wave == 0) {
            int total = 0, before = 0;
            if (lane < NE) for (int bb = 0; bb < T / 64; ++bb) { const int c = cnt[bb * NE + lane]; total += c; before += (bb < tb) ? c : 0; }
            const int padded = (total + 255) & ~255;
            int incl = padded;
#pragma unroll
            for (int o = 1; o < 32; o <<= 1) { const int v = __builtin_amdgcn_ds_bpermute(((lane - o) & 63) << 2, incl); if ((lane & 31) >= o) incl += v; }
            const int base = incl - padded;
            int start = base + before;
            if (tb == 0 && blockIdx.x == 0) {
                if (lane < NE) for (int i = 0; i < (padded >> 8); ++i) tile_e[(base >> 8) + i] = lane;
                if (lane == NE - 1) tile_e[MAXTILES] = (base + padded) >> 8;
            }
            const int t = tb * 64 + lane;
#pragma unroll
            for (int slot = 0; slot < 2; ++slot) {
                const int e_l = eid[2 * t + slot]; int p = 0;
                for (int e = 0; e < NE; ++e) { const unsigned long long mask = __ballot(e_l == e); const int st = __builtin_amdgcn_readlane(start, e);
                    if (e_l == e) p = st + __popcll(mask & ((1ull << lane) - 1ull)); if (lane == e) start += __popcll(mask); }
                pos[2 * t + slot] = p; gwt[p] = ew[2 * t + slot]; posl[slot * 64 + lane] = p;
            }
        }
        __syncthreads();
        for (int i = wave; i < 128; i += NWAVES) { const int t = tb * 64 + (i & 63), p = posl[i];
            const u32x4* src = (const u32x4*)(h2 + (size_t)t * D) + lane; u32x4* dst = (u32x4*)(hs + (size_t)p * D) + lane;
#pragma unroll
            for (int j = 0; j < 4; ++j) dst[64 * j] = src[64 * j]; }
    }
}
__device__ __forceinline__ void combine_rows(float* __restrict__ x, const bf16* __restrict__ ym, const int* __restrict__ pos, const float* __restrict__ gate  , int wv) {
    const int tid = otid(wv), lane = tid & 63, gw = blockIdx.x * NWAVES + (tid >> 6), NGW = gridDim.x * NWAVES;
    for (int t = gw; t < T; t += NGW) {
        const int p0 = pos[2 * t], p1 = pos[2 * t + 1]; const float* gb = gate + (t >> 12) * 12288;
#pragma unroll
        for (int j = 0; j < 8; ++j) { const int c = 4 * lane + 256 * j;
            const u32x2 y0 = *(const u32x2*)(ym + (size_t)p0 * D + c), y1 = *(const u32x2*)(ym + (size_t)p1 * D + c);
            const f32x4 s = {bflo(y0.x) + bflo(y1.x), bfhi(y0.x) + bfhi(y1.x), bflo(y0.y) + bflo(y1.y), bfhi(y0.y) + bfhi(y1.y)};
            f32x4* xp = (f32x4*)(x + (size_t)t * D + c); *xp = *xp + *(const f32x4*)(gb + c) * s; }
    }
}

__global__ void __launch_bounds__(NTHREADS, 2) fwd_kernel(Args a) {
    extern __shared__ __attribute__((aligned(16))) unsigned char lds_raw[];
    LAS unsigned char* lds = (LAS unsigned char*)lds_raw;
    unsigned char* ws = a.ws;
    const int lo = a.ph_lo, hi = a.ph_hi;
    const int wv = __builtin_amdgcn_readfirstlane((int)threadIdx.x >> 6);
    if (threadIdx.x < 4) ((LAS unsigned*)(lds + LDS_BARW))[threadIdx.x] = 0u;
    __syncthreads();
    XcdBarrier bar; bar.bar = (unsigned*)(ws + WS_CTL) + CW_BAR; bar.x = 0; bar.st = nullptr;
    if (hi - lo > 1) bar = xcd_barrier_post((unsigned*)(ws + WS_CTL) + CW_BAR, (volatile LAS unsigned*)(lds + LDS_BARW));
#define IN(k) (lo <= (k) && (k) < hi)
#define SEAM(k) do { if (IN(k) && IN((k) + 1)) xcd_barrier(bar); } while (0)
    const float* mod = (const float*)(ws + WS_MOD);
    if (IN(0)) { p0a(a, lds, wv); } SEAM(0);
    if (IN(1)) { p0b(a, wv); } SEAM(1);
    for (int l = 0; l < NL; ++l) {
        const int pb = PH_L0 + l * PH_PER_LAYER; const float* modl = mod + l * 4 * 12288;
        const float* xin = (l == 0) ? a.in[I_X] : a.out;
        if (IN(pb + 0)) adaln_rows(xin, a.in[I_N1G] + l * D, modl, 0, 2048, (bf16*)(ws + WS_H), wv); SEAM(pb + 0);
        if (IN(pb + 1)) { EpiInProj E{(bf16*)(ws + WS_CQ), (bf16*)(ws + WS_CKV), (bf16*)(ws + WS_KPE), (bf16*)(ws + WS_QR), (bf16*)(ws + WS_KR), (bf16*)(ws + WS_VR), (bf16*)(ws + WS_GR),
                                      (const float*)(ws + WS_C64), (const float*)(ws + WS_S64), (const float*)(ws + WS_C32), (const float*)(ws + WS_S32)};
            fgemm(lds, (const bf16*)(ws + WS_H), D, (const bf16*)(ws + WS_WIN + l * SZ_WIN), D, T, INP, D, E, wv); } SEAM(pb + 1);
        if (IN(pb + 2)) stats_rows((const bf16*)(ws + WS_CQ), (const bf16*)(ws + WS_CKV), (float*)(ws + WS_RQ), (float*)(ws + WS_RKV), wv); SEAM(pb + 2);
        if (IN(pb + 3)) {
            { EpiQ E{(bf16*)(ws + WS_QN), (bf16*)(ws + WS_QP), (const float*)(ws + WS_RQ), (const float*)(ws + WS_C32), (const float*)(ws + WS_S32)};
              fgemm(lds, (const bf16*)(ws + WS_CQ), 512, (const bf16*)(ws + WS_WUQ + l * SZ_WUQ), 512, T, 1536, 512, E, wv); }
            { EpiKV E{(bf16*)(ws + WS_KN), (bf16*)(ws + WS_V), (const float*)(ws + WS_RKV)};
              fgemm(lds, (const bf16*)(ws + WS_CKV), 256, (const bf16*)(ws + WS_WUKV + l * SZ_WUKV), 256, T, 2048, 256, E, wv); }
            ret_phase<true>(ws, lds, wv);
        } SEAM(pb + 3);
        if (IN(pb + 4)) { attn_phase(ws, lds, wv); ret_phase<false>(ws, lds, wv); } SEAM(pb + 4);
        if (IN(pb + 5)) { EpiWo E{xin, a.out, modl + 4096};
            fgemm(lds, (const bf16*)(ws + WS_Y), D, (const bf16*)(ws + WS_WO + l * SZ_WO), D, T, D, D, E, wv); } SEAM(pb + 5);
        if (IN(pb + 6)) adaln_rows(a.out, a.in[I_N2G] + l * D, modl, 3 * 2048, 4 * 2048, (bf16*)(ws + WS_H), wv); SEAM(pb + 6);
        if (IN(pb + 7)) { EpiLogits E{(float*)(ws + WS_LOGITS)};
            fgemm(lds, (const bf16*)(ws + WS_H), D, (const bf16*)(ws + WS_WR + l * SZ_WR), D, T, 256, D, E, wv); } SEAM(pb + 7);
        if (IN(pb + 8)) select_phase(a, l, wv); SEAM(pb + 8);
        if (IN(pb + 9)) dispatch_phase(a, lds, wv); SEAM(pb + 9);
        if (IN(pb + 10)) { const int* tile_e = (const int*)(ws + WS_TILE); const int nt = tile_e[MAXTILES];
            EpiGateUp E{(bf16*)(ws + WS_HID), (const float*)(ws + WS_GW)};
            fgemm_moe(lds, (const bf16*)(ws + WS_HS), D, (const bf16*)(ws + WS_WGU + l * SZ_WGU), D, tile_e, 4, D, E, wv); (void)nt; } SEAM(pb + 10);
        if (IN(pb + 11)) { const int* tile_e = (const int*)(ws + WS_TILE); const int nt = tile_e[MAXTILES];
            EpiDown E{(bf16*)(ws + WS_YM)};
            fgemm_moe(lds, (const bf16*)(ws + WS_HID), DE, (const bf16*)(ws + WS_WD + l * SZ_WD), DE, tile_e, 8, DE, E, wv); (void)nt; } SEAM(pb + 11);
        if (IN(pb + 12)) combine_rows(a.out, (const bf16*)(ws + WS_YM), (const int*)(ws + WS_POS), modl + 5 * 2048, wv); SEAM(pb + 12);
    }
    if (IN(PH_FINAL)) final_rows(a.out, a.in[I_FNG], wv);
#undef IN
#undef SEAM
}

extern "C" void kernel_launch(void* const* d_in, const int* in_sizes, int n_in, void* d_out, int out_size, void* d_ws, size_t ws_size, hipStream_t stream) {
    static int grid = 0;
    if (grid == 0) {
        if (n_in != 20 || out_size != T * D || ws_size < WS_END) { fprintf(stderr, "kernel_launch: unexpected shapes: n_in %d out %d ws %zu (need %zu)\n", n_in, out_size, ws_size, (size_t)WS_END); grid = -1; return; }
        int dev = 0, cus = 0, per_cu = 0;
        if (hipGetDevice(&dev) != hipSuccess || hipDeviceGetAttribute(&cus, hipDeviceAttributeMultiprocessorCount, dev) != hipSuccess) { grid = -1; return; }
        if (hipFuncSetAttribute((const void*)fwd_kernel, hipFuncAttributeMaxDynamicSharedMemorySize, LDS_BYTES) != hipSuccess) { fprintf(stderr, "kernel_launch: hipFuncSetAttribute failed\n"); grid = -1; return; }
        if (hipOccupancyMaxActiveBlocksPerMultiprocessor(&per_cu, (const void*)fwd_kernel, NTHREADS, LDS_BYTES) != hipSuccess || per_cu < 1) { fprintf(stderr, "kernel_launch: occupancy query says %d\n", per_cu); }
        (void)hipGetLastError();
        grid = cus;
    }
    if (grid < 0) return;
    if (hipMemsetAsync((char*)d_ws + WS_CTL, 0, CTL_ZERO_BYTES, stream) != hipSuccess) return;
    Args a{};
    for (int i = 0; i < 20; ++i) a.in[i] = (const float*)d_in[i];
    a.out = (float*)d_out; a.ws = (unsigned char*)d_ws;
#if MK_ONE_LAUNCH
    a.ph_lo = 0; a.ph_hi = NPHASE;
    hipLaunchKernelGGL(fwd_kernel, dim3(grid), dim3(NTHREADS), LDS_BYTES, stream, a);
#else
    for (int ph = 0; ph < NPHASE; ++ph) { a.ph_lo = ph; a.ph_hi = ph + 1;
        hipLaunchKernelGGL(fwd_kernel, dim3(grid), dim3(NTHREADS), LDS_BYTES, stream, a); }
#endif
    const hipError_t le = hipPeekAtLastError();
    if (le != hipSuccess) fprintf(stderr, "kernel_launch: launch failed: %s\n", hipGetErrorName(le));
}
```
